# Optimizing an MI355X kernel written in HIP

```python
import math
import jax, jax.numpy as jnp
from jax import lax
import numpy as np

D_MODEL = 1024
BATCH = 8
SEQ = 2048
DEPTH = 2

GRID_W = 64
CTX_LEN = 256
HEAD_DIM = 64
ROT_PER_AXIS = HEAD_DIM // 2
ROPE_THETA = 10000.0
GDN_HEADS = 8
GDN_DK = 64
GDN_DV = 64
GDN_CONV = 5
GDN_CHUNK = 64
GA_HEADS = 4
GA_KV = 2
WA_HEADS = 4
WA_KV = 2
WINDOW = 128
Q_BLOCK = 128
D_FF = 4 * D_MODEL
N_MOD = 6
RMS_EPS = 1e-6
A_QKV = GDN_HEADS * (2 * GDN_DK + GDN_DV)
A_Z = GDN_HEADS * GDN_DV
A_GATES = 2 * GDN_HEADS
B_QKV = (GA_HEADS + 2 * GA_KV) * HEAD_DIM
C_QKV = (WA_HEADS + 2 * WA_KV) * HEAD_DIM
D_IN = A_QKV + A_Z + 2 * A_GATES + B_QKV + C_QKV
D_MIX = GDN_HEADS * GDN_DV + GA_HEADS * HEAD_DIM + WA_HEADS * HEAD_DIM

kernel_name = "hybrid_gdn_gqa_swa_flow_block"


def rms_norm(x, g):
    xf = x.astype(jnp.float32)
    y = xf * lax.rsqrt(jnp.mean(jnp.square(xf), axis=-1, keepdims=True) + RMS_EPS)
    return (y * g.astype(jnp.float32)).astype(x.dtype)


def modulate(x, g, shift, scale):
    return rms_norm(x, g) * (1 + scale) + shift


def ada_mod(cond, w_mod, b_mod):
    return jnp.split(jax.nn.silu(cond) @ w_mod + b_mod, N_MOD, axis=-1)


def split_cols(p):
    sizes = (A_QKV, A_Z, A_GATES, A_GATES, B_QKV, C_QKV)
    offsets = [int(o) for o in np.cumsum(sizes)[:-1]]
    return jnp.split(p, offsets, axis=-1)


def l2_normalize(x):
    return x * lax.rsqrt(jnp.sum(jnp.square(x), axis=-1, keepdims=True) + 1e-6)


def short_conv(x, w):
    pad = GDN_CONV // 2
    t = x.shape[1]
    xp = jnp.pad(x, ((0, 0), (pad, pad), (0, 0)))
    return sum(xp[:, j:j + t] * w[j] for j in range(GDN_CONV))


def axial_rope_tables(rows, dtype):
    row = jnp.repeat(jnp.arange(rows, dtype=jnp.float32), GRID_W)
    col = jnp.tile(jnp.arange(GRID_W, dtype=jnp.float32), rows)
    half = ROT_PER_AXIS // 2
    inv_freq = ROPE_THETA ** (-jnp.arange(half, dtype=jnp.float32) / half)
    ang_r = row[:, None] * inv_freq
    ang_c = col[:, None] * inv_freq
    return tuple(a[:, None, :].astype(dtype) for a in
                 (jnp.cos(ang_r), jnp.sin(ang_r), jnp.cos(ang_c), jnp.sin(ang_c)))


def _rotate(x, cos, sin):
    x1, x2 = jnp.split(x, 2, axis=-1)
    return jnp.concatenate([x1 * cos - x2 * sin, x2 * cos + x1 * sin], axis=-1)


def apply_axial_rope(x, rope):
    cos_r, sin_r, cos_c, sin_c = rope
    return jnp.concatenate([_rotate(x[..., :ROT_PER_AXIS], cos_r, sin_r),
                            _rotate(x[..., ROT_PER_AXIS:], cos_c, sin_c)], axis=-1)


def gated_delta_chunked(q, k, v, g, beta, s0):
    b, t, h, dk = k.shape
    dv = v.shape[-1]
    n = t // GDN_CHUNK

    def chunks(a):
        a = a.reshape((b, n, GDN_CHUNK, h) + a.shape[3:])
        return jnp.moveaxis(a, (1, 3), (0, 2))

    kc, vc, gc, bc = chunks(k), chunks(v), chunks(g), chunks(beta)
    gcum = jnp.cumsum(gc, axis=-1)
    idx = jnp.arange(GDN_CHUNK)
    incl = idx[:, None] >= idx[None, :]
    decay = jnp.exp(jnp.where(incl, gcum[..., :, None] - gcum[..., None, :], -jnp.inf))
    kb = kc * bc[..., None]
    low = jnp.where(idx[:, None] > idx[None, :], jnp.einsum("nbhid,nbhjd->nbhij", kb, kc) * decay, 0.0)
    eye = jnp.eye(GDN_CHUNK, dtype=low.dtype)
    rhs = jnp.concatenate([vc * bc[..., None], kb * jnp.exp(gcum)[..., None]], axis=-1)
    sol = lax.linalg.triangular_solve(eye + low, rhs, left_side=True, lower=True, unit_diagonal=True)
    u, w = sol[..., :dv], sol[..., dv:]
    g_last = gcum[..., -1]
    k_end = kc * jnp.exp(g_last[..., None] - gcum)[..., None]

    def update(s, u_i, w_i, ke_i, gl_i):
        v_new = u_i - jnp.einsum("bhck,bhkv->bhcv", w_i, s)
        s_new = s * jnp.exp(gl_i)[..., None, None] + jnp.einsum("bhck,bhcv->bhkv", ke_i, v_new)
        return s_new, v_new

    if q is None:
        def step_state(s, xs):
            s_new, _ = update(s, *xs)
            return s_new, None
        s_fin, _ = lax.scan(step_state, s0, (u, w, k_end, g_last))
        return None, s_fin

    qc = chunks(q)
    intra = jnp.einsum("nbhid,nbhjd->nbhij", qc, kc) * decay
    q_dec = qc * jnp.exp(gcum)[..., None]

    def step(s, xs):
        u_i, w_i, ke_i, gl_i, q_i, a_i = xs
        s_new, v_new = update(s, u_i, w_i, ke_i, gl_i)
        o_i = jnp.einsum("bhck,bhkv->bhcv", q_i, s) + jnp.einsum("bhij,bhjv->bhiv", a_i, v_new)
        return s_new, o_i

    s_fin, o = lax.scan(step, s0, (u, w, k_end, g_last, q_dec, intra))
    return jnp.moveaxis(o, (0, 2), (1, 3)).reshape(b, t, h, dv), s_fin


def gdn_heads(qkv, beta_raw, alpha_raw, conv_w, a_log, dt_bias, with_q):
    b, t, _ = qkv.shape
    f32 = jnp.float32
    qkv = jax.nn.silu(short_conv(qkv, conv_w)).astype(f32)
    q, k, v = jnp.split(qkv, [GDN_HEADS * GDN_DK, 2 * GDN_HEADS * GDN_DK], axis=-1)
    k = l2_normalize(k.reshape(b, t, GDN_HEADS, GDN_DK))
    v = v.reshape(b, t, GDN_HEADS, GDN_DV)
    q = l2_normalize(q.reshape(b, t, GDN_HEADS, GDN_DK)) * GDN_DK ** -0.5 if with_q else None
    beta = jax.nn.sigmoid(beta_raw.astype(f32)).reshape(b, t, 2, GDN_HEADS)
    g = -jnp.exp(a_log.astype(f32)) * jax.nn.softplus(
        alpha_raw.astype(f32).reshape(b, t, 2, GDN_HEADS) + dt_bias.astype(f32))
    return q, k, v, g, beta


def direction_inputs(heads, d):
    q, k, v, g, beta = heads
    f = lambda a: None if a is None else (jnp.flip(a, axis=1) if d == 1 else a)
    return f(q), f(k), f(v), f(g[:, :, d]), f(beta[:, :, d])


def gated_out_norm(o, z, gain):
    b, t, h, dv = o.shape
    y = rms_norm(o, gain) * jax.nn.silu(z.reshape(b, t, h, dv).astype(jnp.float32))
    return y.reshape(b, t, h * dv).astype(z.dtype)


def gdn_mixer(a_qkv, a_z, a_beta, a_alpha, ca_qkv, ca_z, ca_beta, ca_alpha,
              conv_w, a_log, dt_bias, norm_g, need_ctx_out):
    lat = gdn_heads(a_qkv, a_beta, a_alpha, conv_w, a_log, dt_bias, True)
    ctxh = gdn_heads(ca_qkv, ca_beta, ca_alpha, conv_w, a_log, dt_bias, need_ctx_out)
    s0 = jnp.zeros((a_qkv.shape[0], GDN_HEADS, GDN_DK, GDN_DV), jnp.float32)
    o_lat, o_ctx = None, None
    for d in range(2):
        oc, sc = gated_delta_chunked(*direction_inputs(ctxh, d), s0)
        ol, _ = gated_delta_chunked(*direction_inputs(lat, d), sc)
        ol = jnp.flip(ol, axis=1) if d == 1 else ol
        o_lat = ol if o_lat is None else o_lat + ol
        if need_ctx_out:
            oc = jnp.flip(oc, axis=1) if d == 1 else oc
            o_ctx = oc if o_ctx is None else o_ctx + oc
    out = gated_out_norm(o_lat, a_z, norm_g)
    out_c = gated_out_norm(o_ctx, ca_z, norm_g) if need_ctx_out else None
    return out, out_c


def attn_heads(p, n_q, n_kv, qg, kg, rope, with_q):
    b, t, _ = p.shape
    q, k, v = jnp.split(p, [n_q * HEAD_DIM, (n_q + n_kv) * HEAD_DIM], axis=-1)
    k = rms_norm(k.reshape(b, t, n_kv, HEAD_DIM), kg)
    v = v.reshape(b, t, n_kv, HEAD_DIM)
    q = rms_norm(q.reshape(b, t, n_q, HEAD_DIM), qg) if with_q else None
    if rope is not None:
        k = apply_axial_rope(k, rope)
        q = apply_axial_rope(q, rope)
    return q, k, v


def global_gqa(q, k, v, qc, kc, vc):
    b, t, hq, dh = q.shape
    hkv = k.shape[2]
    grp = hq // hkv
    scale = dh ** -0.5
    k_all = jnp.concatenate([k, kc], axis=1)
    v_all = jnp.concatenate([v, vc], axis=1)

    def block(qi):
        s = jnp.einsum("bqhgd,bkhd->bhgqk", qi, k_all).astype(jnp.float32) * scale
        p = jax.nn.softmax(s, axis=-1).astype(v_all.dtype)
        return jnp.einsum("bhgqk,bkhd->bqhgd", p, v_all)

    nb = t // Q_BLOCK
    qb = jnp.moveaxis(q.reshape(b, nb, Q_BLOCK, hkv, grp, dh), 1, 0)
    o = jnp.moveaxis(lax.map(block, qb), 0, 1).reshape(b, t, hq * dh)
    o_ctx = None
    if qc is not None:
        lc = qc.shape[1]
        s = jnp.einsum("bqhgd,bkhd->bhgqk", qc.reshape(b, lc, hkv, grp, dh), kc).astype(jnp.float32) * scale
        p = jax.nn.softmax(s, axis=-1).astype(vc.dtype)
        o_ctx = jnp.einsum("bhgqk,bkhd->bqhgd", p, vc).reshape(b, lc, hq * dh)
    return o, o_ctx


def window_gqa(q, k, v, qc, kc, vc, sink):
    b, t, hq, dh = q.shape
    hkv = k.shape[2]
    grp = hq // hkv
    scale = dh ** -0.5
    f32 = jnp.float32
    nb = t // Q_BLOCK
    wb = WINDOW // Q_BLOCK
    nkb = 2 * wb + 1
    pad = ((0, 0), (wb * Q_BLOCK, wb * Q_BLOCK), (0, 0), (0, 0))

    def band(a):
        ap = jnp.pad(a, pad).reshape(b, nb + 2 * wb, Q_BLOCK, hkv, dh)
        return jnp.concatenate([ap[:, j:j + nb] for j in range(nkb)], axis=2)

    kw, vw = band(k), band(v)
    qi = jnp.arange(Q_BLOCK)
    kj = jnp.arange(nkb * Q_BLOCK) - wb * Q_BLOCK
    kpos = jnp.arange(nb)[:, None] * Q_BLOCK + kj[None, :]
    valid = (jnp.abs(kj[None, :] - qi[:, None]) <= WINDOW)[None] & ((kpos >= 0) & (kpos < t))[:, None, :]
    qb = q.reshape(b, nb, Q_BLOCK, hkv, grp, dh)
    s_win = jnp.einsum("bnqhgd,bnkhd->bnhgqk", qb, kw).astype(f32) * scale
    s_win = jnp.where(valid[None, :, None, None], s_win, -jnp.inf)
    s_ctx = jnp.einsum("bnqhgd,bchd->bnhgqc", qb, kc).astype(f32) * scale
    sink_col = jnp.broadcast_to(sink.astype(f32).reshape(hkv, grp, 1), s_win.shape[:-1])[..., None]
    p = jax.nn.softmax(jnp.concatenate([s_win, s_ctx, sink_col], axis=-1), axis=-1).astype(v.dtype)
    kwn = kw.shape[2]
    lc = kc.shape[1]
    o = (jnp.einsum("bnhgqk,bnkhd->bnqhgd", p[..., :kwn], vw)
         + jnp.einsum("bnhgqc,bchd->bnqhgd", p[..., kwn:kwn + lc], vc)).reshape(b, t, hq * dh)
    o_ctx = None
    if qc is not None:
        s = jnp.einsum("bqhgd,bkhd->bhgqk", qc.reshape(b, lc, hkv, grp, dh), kc).astype(f32) * scale
        sc = jnp.broadcast_to(sink.astype(f32).reshape(hkv, grp, 1), s.shape[:-1])[..., None]
        pc = jax.nn.softmax(jnp.concatenate([s, sc], axis=-1), axis=-1).astype(vc.dtype)
        o_ctx = jnp.einsum("bhgqk,bkhd->bqhgd", pc[..., :lc], vc).reshape(b, lc, hq * dh)
    return o, o_ctx


def sq_relu_mlp(h, w1, w2):
    return jnp.square(jax.nn.relu(h @ w1)) @ w2


def hybrid_layer(x, cx, cond, cond_ctx, rope, w_mod, b_mod, g_attn, w_in, gdn_conv_w, gdn_a_log,
                 gdn_dt_bias, gdn_norm_g, ga_q_norm_g, ga_k_norm_g, wa_q_norm_g, wa_k_norm_g, wa_sink,
                 w_out, g_mlp, w_mlp_in, w_mlp_out, need_ctx_out):
    sh_a, sc_a, gt_a, sh_m, sc_m, gt_m = ada_mod(cond, w_mod, b_mod)
    csh_a, csc_a, cgt_a, csh_m, csc_m, cgt_m = ada_mod(cond_ctx, w_mod, b_mod)
    a_qkv, a_z, a_beta, a_alpha, b_qkv, c_qkv = split_cols(modulate(x, g_attn, sh_a, sc_a) @ w_in)
    ca_qkv, ca_z, ca_beta, ca_alpha, cb_qkv, cc_qkv = split_cols(modulate(cx, g_attn, csh_a, csc_a) @ w_in)
    o_a, oc_a = gdn_mixer(a_qkv, a_z, a_beta, a_alpha, ca_qkv, ca_z, ca_beta, ca_alpha,
                          gdn_conv_w, gdn_a_log, gdn_dt_bias, gdn_norm_g, need_ctx_out)
    q, k, v = attn_heads(b_qkv, GA_HEADS, GA_KV, ga_q_norm_g, ga_k_norm_g, rope, True)
    qc, kc, vc = attn_heads(cb_qkv, GA_HEADS, GA_KV, ga_q_norm_g, ga_k_norm_g, None, need_ctx_out)
    o_b, oc_b = global_gqa(q, k, v, qc, kc, vc)
    q, k, v = attn_heads(c_qkv, WA_HEADS, WA_KV, wa_q_norm_g, wa_k_norm_g, rope, True)
    qc, kc, vc = attn_heads(cc_qkv, WA_HEADS, WA_KV, wa_q_norm_g, wa_k_norm_g, None, need_ctx_out)
    o_c, oc_c = window_gqa(q, k, v, qc, kc, vc, wa_sink)
    x = x + gt_a * (jnp.concatenate([o_a, o_b, o_c], axis=-1) @ w_out)
    x = x + gt_m * sq_relu_mlp(modulate(x, g_mlp, sh_m, sc_m), w_mlp_in, w_mlp_out)
    if need_ctx_out:
        cx = cx + cgt_a * (jnp.concatenate([oc_a, oc_b, oc_c], axis=-1) @ w_out)
        cx = cx + cgt_m * sq_relu_mlp(modulate(cx, g_mlp, csh_m, csc_m), w_mlp_in, w_mlp_out)
    return x, cx


def setup_inputs(seed: int = 0) -> dict:
    key = jax.random.key(seed)
    ks = jax.random.split(key, 24)
    f32 = jnp.float32
    L = DEPTH

    def nrm(k, shape, scale):
        return jax.random.normal(k, shape, f32) * scale

    def gain(k, shape):
        return 1.0 + 0.02 * jax.random.normal(k, shape, f32)

    dt = jnp.exp(jax.random.uniform(ks[10], (L, 2, GDN_HEADS), f32, math.log(1e-3), math.log(1e-1)))
    return {
        "x": nrm(ks[0], (BATCH, SEQ, D_MODEL), 1.0),
        "c": nrm(ks[1], (BATCH, D_MODEL), 1.0),
        "ctx": nrm(ks[2], (BATCH, CTX_LEN, D_MODEL), 1.0),
        "c_ctx": nrm(ks[3], (D_MODEL,), 1.0),
        "w_mod": nrm(ks[4], (L, D_MODEL, N_MOD * D_MODEL), 0.5 * D_MODEL ** -0.5),
        "b_mod": nrm(ks[5], (L, N_MOD * D_MODEL), 0.01),
        "g_attn": gain(ks[6], (L, D_MODEL)),
        "w_in": nrm(ks[7], (L, D_MODEL, D_IN), D_MODEL ** -0.5),
        "gdn_conv_w": nrm(ks[8], (L, GDN_CONV, A_QKV), GDN_CONV ** -0.5),
        "gdn_a_log": jnp.log(jax.random.uniform(ks[9], (L, 2, GDN_HEADS), f32, 1.0, 16.0)),
        "gdn_dt_bias": dt + jnp.log(-jnp.expm1(-dt)),
        "gdn_norm_g": gain(ks[11], (L, GDN_DV)),
        "ga_q_norm_g": gain(ks[12], (L, HEAD_DIM)),
        "ga_k_norm_g": gain(ks[13], (L, HEAD_DIM)),
        "wa_q_norm_g": gain(ks[14], (L, HEAD_DIM)),
        "wa_k_norm_g": gain(ks[15], (L, HEAD_DIM)),
        "wa_sink": nrm(ks[16], (L, WA_HEADS), 1.0),
        "w_out": nrm(ks[17], (L, D_MIX, D_MODEL), D_MIX ** -0.5),
        "g_mlp": gain(ks[18], (L, D_MODEL)),
        "w_mlp_in": nrm(ks[19], (L, D_MODEL, D_FF), D_MODEL ** -0.5),
        "w_mlp_out": nrm(ks[20], (L, D_FF, D_MODEL), D_FF ** -0.5),
    }


def reference(x, c, ctx, c_ctx, w_mod, b_mod, g_attn, w_in, gdn_conv_w, gdn_a_log, gdn_dt_bias,
              gdn_norm_g, ga_q_norm_g, ga_k_norm_g, wa_q_norm_g, wa_k_norm_g, wa_sink, w_out, g_mlp,
              w_mlp_in, w_mlp_out):
    t = x.shape[1]
    rows = t // GRID_W
    rope = axial_rope_tables(rows, x.dtype)
    cond = c[:, None, :]
    cond_ctx = c_ctx[None, None, :]
    cx = ctx
    for l in range(DEPTH):
        x, cx = hybrid_layer(x, cx, cond, cond_ctx, rope, w_mod[l], b_mod[l], g_attn[l], w_in[l],
                             gdn_conv_w[l], gdn_a_log[l], gdn_dt_bias[l], gdn_norm_g[l],
                             ga_q_norm_g[l], ga_k_norm_g[l], wa_q_norm_g[l], wa_k_norm_g[l], wa_sink[l],
                             w_out[l], g_mlp[l], w_mlp_in[l], w_mlp_out[l], l < DEPTH - 1)
    return x
```

```cpp
#include <hip/hip_runtime.h>
#include <cstdio>
#include <cstdint>

#define GAS __attribute__((address_space(1)))
#define LAS __attribute__((address_space(3)))
typedef unsigned short bf16;
typedef short bf16x8 __attribute__((ext_vector_type(8)));
typedef float f32x4 __attribute__((ext_vector_type(4)));
typedef float f32x16 __attribute__((ext_vector_type(16)));
typedef unsigned v4u __attribute__((ext_vector_type(4)));
typedef GAS unsigned gu32;
#define RLX_AGENT __ATOMIC_RELAXED, __HIP_MEMORY_SCOPE_AGENT
#define LDS_WAIT() asm volatile("s_waitcnt lgkmcnt(0)" ::: "memory")

#ifndef MK_ONE_LAUNCH
#define MK_ONE_LAUNCH 1
#endif
constexpr int NWAVES = 8, NTHREADS = NWAVES * 64;

constexpr int DM = 1024, NB = 8, SEQ = 2048, CTXL = 256, TPB = SEQ + CTXL, NT = NB * TPB;
constexpr int NL = 2, DIN = 3104, NP = 3072, DFF = 4096, NMODC = 6 * DM;
constexpr int GH = 8;
constexpr float RMS_EPS = 1e-6f;
constexpr float C2 = 0.125f * 1.4426950408889634f;
constexpr float LOG2E = 1.4426950408889634f;
constexpr int PC_Z = 1536, PC_B = 2048, PC_C = 2560;
constexpr int NPHASES = 1 + 9 * NL;

constexpr size_t MiB = 1u << 20;
constexpr size_t WS_CTL = 0, CTL_ZERO_BYTES = 1 * MiB;
constexpr size_t WS_MOD = 1 * MiB;
constexpr size_t WS_ROPE = WS_MOD + 512 * 1024;
constexpr size_t WS_WIN = 2 * MiB;
constexpr size_t WS_WOUT = WS_WIN + (size_t)DIN * DM * 2 + 65536;
constexpr size_t WS_W1 = WS_WOUT + (size_t)DM * DM * 2;
constexpr size_t WS_W2 = WS_W1 + (size_t)DFF * DM * 2;
constexpr size_t WS_XSC = 27 * MiB;
constexpr size_t WS_ACT = 35 * MiB;
constexpr size_t WS_G = 71 * MiB;
constexpr size_t WS_P = 74 * MiB;
constexpr size_t WS_OG = 182 * MiB;
constexpr size_t WS_H = 74 * MiB;
constexpr size_t WS_END = 254 * MiB;
static_assert(WS_W2 + (size_t)DM * DFF * 2 <= WS_XSC, "weights");
static_assert(WS_H + (size_t)NT * DFF * 2 <= WS_END && WS_OG + (size_t)2 * NT * 512 * 4 <= WS_END, "ws map");
constexpr int CW_BAR = 4096;

constexpr int LDS_BYTES = 147456;
constexpr int MISC_OFF = 131072 + 320;

__device__ __forceinline__ unsigned f2bf(float f) { unsigned u = __builtin_bit_cast(unsigned, f); return (u + 0x7fffu + ((u >> 16) & 1u)) >> 16; }
__device__ __forceinline__ unsigned pk2(float lo, float hi) { return f2bf(lo) | (f2bf(hi) << 16); }
__device__ __forceinline__ float bf2f(bf16 v) { return __builtin_bit_cast(float, (unsigned)v << 16); }
__device__ __forceinline__ float bfs2f(short v) { return __builtin_bit_cast(float, ((unsigned)(unsigned short)v) << 16); }
__device__ __forceinline__ float wave_sum(float v) {
#pragma unroll
    for (int o = 1; o < 64; o <<= 1) v += __shfl_xor(v, o);
    return v;
}
__device__ __forceinline__ float wave_max(float v) {
#pragma unroll
    for (int o = 1; o < 64; o <<= 1) v = fmaxf(v, __shfl_xor(v, o));
    return v;
}
__device__ __forceinline__ float siluf(float v) { return v / (1.f + __expf(-v)); }

#define XB_TMO      128
#define XB_XCNT(j)  (256  + 64 * (j))
#define XB_XSUB(j)  (1280 + 64 * (j))
#define XB_XGEN(j)  (2304 + 64 * (j))
#define XB_TOP      3328
#define XB_TOPGEN   3392
#define XCD_BAR_WORDS 3456
#define XB_SPIN_CAP (1u << 22)
__device__ __forceinline__ unsigned xb_ld(unsigned* p)              { return __hip_atomic_load(p, __ATOMIC_RELAXED, __HIP_MEMORY_SCOPE_AGENT); }
__device__ __forceinline__ unsigned xb_add(unsigned* p, unsigned v) { return __hip_atomic_fetch_add(p, v, __ATOMIC_RELAXED, __HIP_MEMORY_SCOPE_AGENT); }
__device__ __forceinline__ unsigned xb_xcc_id() { return (unsigned)__builtin_amdgcn_s_getreg((3 << 11) | 20) & 0xFu; }
#define XB_SPIN(cond, bar) do { unsigned _sp = 0; while (cond) { __builtin_amdgcn_s_sleep(1); \
    if ((++_sp & 255u) == 0u) { if (xb_ld(&(bar)[XB_TMO])) break; if (_sp > XB_SPIN_CAP) { atomicAdd(&(bar)[XB_TMO], 1u); break; } } } } while (0)
struct XcdBarrier { unsigned* bar; unsigned x; volatile LAS unsigned* st; };
__device__ __forceinline__ XcdBarrier xcd_barrier_post(unsigned* bar, volatile LAS unsigned* st) {
    XcdBarrier b; b.bar = bar; b.x = xb_xcc_id(); b.st = st;
    if (threadIdx.x == 0) (void)xb_add(&bar[XB_XCNT(b.x)], 1u);
    return b;
}
__device__ __forceinline__ void xcd_barrier_complete(unsigned* bar, unsigned x, unsigned& nloc, unsigned& nx) {
    const unsigned G = gridDim.x * gridDim.y * gridDim.z;
    unsigned sum, cnt, mine, sp = 0u;
    for (;;) {
        sum = 0u; cnt = 0u; mine = 0u;
#pragma unroll
        for (unsigned j = 0; j < 16; ++j) { const unsigned c = xb_ld(&bar[XB_XCNT(j)]); sum += c; cnt += (c > 0u) ? 1u : 0u; mine = (j == x) ? c : mine; }
        if (sum == G) break;
        __builtin_amdgcn_s_sleep(1);
        if ((++sp & 255u) == 0u) { if (xb_ld(&bar[XB_TMO])) break; if (sp > XB_SPIN_CAP) { atomicAdd(&bar[XB_TMO], 1u); break; } }
    }
    nloc = mine > 0u ? mine : 1u; nx = cnt > 0u ? cnt : 1u;
}
__device__ __forceinline__ void xcd_barrier(const XcdBarrier& b) {
    asm volatile("s_waitcnt vmcnt(0)" ::: "memory");
    __syncthreads();
    if (threadIdx.x == 0) {
        unsigned* bar = b.bar;
        __builtin_amdgcn_s_waitcnt(0);
        unsigned nloc = b.st[0], nx = b.st[1];
        if (nloc == 0u) { xcd_barrier_complete(bar, b.x, nloc, nx); b.st[0] = nloc; b.st[1] = nx; }
        const unsigned old = xb_add(&bar[XB_XSUB(b.x)], 1u);
        const unsigned gen = old / nloc;
        if (old + 1u == (gen + 1u) * nloc) {
            __builtin_amdgcn_fence(__ATOMIC_RELEASE, "agent");
            asm volatile("s_waitcnt vmcnt(0)" ::: "memory");
            const unsigned og = xb_add(&bar[XB_TOP], 1u);
            const unsigned tg = og / nx;
            if (og + 1u == (tg + 1u) * nx) xb_add(&bar[XB_TOPGEN], 1u);
            else XB_SPIN(xb_ld(&bar[XB_TOPGEN]) == tg, bar);
            __builtin_amdgcn_fence(__ATOMIC_ACQUIRE, "agent");
            xb_add(&bar[XB_XGEN(b.x)], 1u);
            asm volatile("s_waitcnt vmcnt(0)" ::: "memory");
        } else {
            XB_SPIN(xb_ld(&bar[XB_XGEN(b.x)]) == gen, bar);
            __builtin_amdgcn_fence(__ATOMIC_ACQUIRE, "agent");
            asm volatile("s_waitcnt vmcnt(0)" ::: "memory");
        }
    }
    __syncthreads();
}

struct Args { const float* in[21]; float* out; unsigned char* ws; int ph_lo, ph_hi, li, pad; };
struct Ctx {
    LAS unsigned char* lds;
    int tid, lane, wave, G, bx, gw, NGW;
    const Args& A;
    __device__ __forceinline__ Ctx(const Args& a) : A(a) {}
};
#define c_in(i)  (c.A.in[i])
#define c_out    (c.A.out)
#define c_Win_t  ((bf16*)(c.A.ws + WS_WIN))
#define c_Wout_t ((bf16*)(c.A.ws + WS_WOUT))
#define c_W1_t   ((bf16*)(c.A.ws + WS_W1))
#define c_W2_t   ((bf16*)(c.A.ws + WS_W2))
#define c_ACT    ((bf16*)(c.A.ws + WS_ACT))
#define c_P      ((bf16*)(c.A.ws + WS_P))
#define c_H      ((bf16*)(c.A.ws + WS_H))
#define c_XSC    ((float*)(c.A.ws + WS_XSC))
#define c_Gt     ((float*)(c.A.ws + WS_G))
#define c_OG     ((float*)(c.A.ws + WS_OG))
#define c_MOD    ((float*)(c.A.ws + WS_MOD))
#define c_ROPE   ((float*)(c.A.ws + WS_ROPE))
__device__ __forceinline__ float* xs_row(const Ctx& c, int R) {
    const int b = R / TPB, tp = R - b * TPB;
    return tp < CTXL ? c_XSC + ((size_t)(b * CTXL + tp) << 10) : c_out + ((size_t)(b * SEQ + tp - CTXL) << 10);
}
__device__ __forceinline__ const float* in_row(const Ctx& c, int R) {
    const int b = R / TPB, tp = R - b * TPB;
    return tp < CTXL ? c_in(2) + ((size_t)(b * CTXL + tp) << 10) : c_in(0) + ((size_t)(b * SEQ + tp - CTXL) << 10);
}
__device__ __forceinline__ int mod_row(int R) { const int b = R / TPB, tp = R - b * TPB; return tp < CTXL ? 8 : b; }

__device__ __forceinline__ void transpose_item(const float* W, int K, int N, bf16* WT, int k0, int n0, int n0d, LAS float* scr, int lane) {
#pragma unroll 8
    for (int i = 0; i < 32; ++i) { const int kk = 2 * i + (lane >> 5); scr[kk * 33 + (lane & 31)] = W[(size_t)(k0 + kk) * N + n0 + (lane & 31)]; }
    LDS_WAIT(); asm volatile("" ::: "memory");
    const int cch = lane & 7;
#pragma unroll
    for (int j = 0; j < 4; ++j) { const int n = (lane >> 3) + 8 * j; const LAS float* s = scr + (8 * cch) * 33 + n;
        v4u o; o.x = pk2(s[0 * 33], s[1 * 33]); o.y = pk2(s[2 * 33], s[3 * 33]); o.z = pk2(s[4 * 33], s[5 * 33]); o.w = pk2(s[6 * 33], s[7 * 33]);
        *(GAS v4u*)(WT + (size_t)(n0d + n) * K + k0 + 8 * cch) = o; }
    LDS_WAIT(); asm volatile("" ::: "memory");
}
__device__ __forceinline__ void conv_weights(Ctx& c, int l) {
    LAS float* scr = (LAS float*)(c.lds + c.wave * 16384);
    constexpr int I_IN = 16 * 97, I_O = 16 * 32, I_1 = 16 * 128, I_2 = 64 * 32, NITEMS = I_IN + I_O + I_1 + I_2;
    const float* w_in = c_in(7) + (size_t)l * DM * DIN; const float* w_out = c_in(17) + (size_t)l * DM * DM;
    const float* w1 = c_in(19) + (size_t)l * DM * DFF; const float* w2 = c_in(20) + (size_t)l * DFF * DM;
    for (int it = c.gw; it < NITEMS; it += c.NGW) {
        int r = it;
        if (r < I_IN) { const int kb = r / 97, nb = r % 97; const int nbd = nb < 64 ? nb : (nb == 64 ? 96 : nb - 1);
            transpose_item(w_in, DM, DIN, c_Win_t, 64 * kb, 32 * nb, 32 * nbd, scr, c.lane); continue; } r -= I_IN;
        if (r < I_O) { const int kb = r / 32, nb = r % 32; transpose_item(w_out, DM, DM, c_Wout_t, 64 * kb, 32 * nb, 32 * nb, scr, c.lane); continue; } r -= I_O;
        if (r < I_1) { const int kb = r / 128, nb = r % 128; transpose_item(w1, DM, DFF, c_W1_t, 64 * kb, 32 * nb, 32 * nb, scr, c.lane); continue; } r -= I_1;
        { const int kb = r / 32, nb = r % 32; transpose_item(w2, DFF, DM, c_W2_t, 64 * kb, 32 * nb, 32 * nb, scr, c.lane); }
    }
}
__device__ __forceinline__ void ada_mod_phase(Ctx& c) {
    LAS float* scond = (LAS float*)c.lds; LAS float* red = scond + 9 * 1024;
    if (c.bx < 192) {
        for (int i = c.tid; i < 9 * 1024; i += NTHREADS) { const int r = i >> 10, k = i & 1023; const float v = r < 8 ? c_in(1)[r * 1024 + k] : c_in(3)[k]; scond[i] = siluf(v); }
        __syncthreads();
        for (int u = c.bx; u < 192; u += c.G) {
            const int l = u / 96, cg = u % 96, col = cg * 64 + c.lane;
            const float* w = c_in(4) + (size_t)l * DM * NMODC + col;
            float acc[9];
#pragma unroll
            for (int r = 0; r < 9; ++r) acc[r] = 0.f;
            const int k0 = c.wave * 128;
#pragma unroll 4
            for (int k = k0; k < k0 + 128; ++k) { const float wv = w[(size_t)k * NMODC];
#pragma unroll
                for (int r = 0; r < 9; ++r) acc[r] += scond[r * 1024 + k] * wv; }
#pragma unroll
            for (int r = 0; r < 9; ++r) red[(c.wave * 9 + r) * 64 + c.lane] = acc[r];
            __syncthreads();
            for (int i = c.tid; i < 576; i += NTHREADS) { const int r = i >> 6, ln = i & 63; float s = 0.f;
#pragma unroll
                for (int w8 = 0; w8 < 8; ++w8) s += red[(w8 * 9 + r) * 64 + ln];
                const int cc = cg * 64 + ln; c_MOD[(size_t)(l * 9 + r) * NMODC + cc] = s + c_in(5)[l * NMODC + cc]; }
            __syncthreads();
        }
    }
    const int gid = c.bx * NTHREADS + c.tid;
    if (gid < 96 * 16) { const int pos = gid >> 4, i = gid & 15; const float inv = powf(10000.f, -(float)i / 16.f);
        const float p = (float)(pos < 32 ? pos : pos - 32); const float a = p * inv; c_ROPE[2 * gid] = cosf(a); c_ROPE[2 * gid + 1] = sinf(a); }
}

__device__ __forceinline__ void norm_phase(Ctx& c, int l, int which  ) {
    const float* g = (which == 0 ? c_in(6) : c_in(18)) + l * DM;
    const bool skip_ctx = (which == 1 && l == NL - 1);
    for (int R = c.gw; R < NT; R += c.NGW) {
        const int b = R / TPB, tp = R - b * TPB;
        if (skip_ctx && tp < CTXL) continue;
        const bool first = (l == 0 && which == 0);
        const float* src = first ? in_row(c, R) : xs_row(c, R);
        const f32x4* xr = (const f32x4*)src + c.lane;
        f32x4 v[4]; float ss = 0.f;
#pragma unroll
        for (int j = 0; j < 4; ++j) { v[j] = xr[64 * j]; ss += (v[j].x * v[j].x + v[j].y * v[j].y) + (v[j].z * v[j].z + v[j].w * v[j].w); }
        if (first) { f32x4* xo = (f32x4*)xs_row(c, R) + c.lane;
#pragma unroll
            for (int j = 0; j < 4; ++j) xo[64 * j] = v[j]; }
        const float rstd = rsqrtf(wave_sum(ss) * (1.f / DM) + RMS_EPS);
        const int rb = tp < CTXL ? 8 : b;
        const float* mrow = c_MOD + (size_t)(l * 9 + rb) * NMODC + (which == 0 ? 0 : 3 * DM);
        unsigned long long* o8 = (unsigned long long*)(c_ACT + (size_t)R * DM) + c.lane;
#pragma unroll
        for (int j = 0; j < 4; ++j) { const int col = 4 * c.lane + 256 * j;
            const f32x4 gg = *(const f32x4*)(g + col), sh = *(const f32x4*)(mrow + col), sc = *(const f32x4*)(mrow + DM + col);
            const float y0 = v[j].x * rstd * gg.x * (1.f + sc.x) + sh.x, y1 = v[j].y * rstd * gg.y * (1.f + sc.y) + sh.y;
            const float y2 = v[j].z * rstd * gg.z * (1.f + sc.z) + sh.z, y3 = v[j].w * rstd * gg.w * (1.f + sc.w) + sh.w;
            o8[64 * j] = (unsigned long long)pk2(y0, y1) | ((unsigned long long)pk2(y2, y3) << 32); }
    }
}

template <class Epi>
__device__ __forceinline__ void gemm_naive(const Ctx& c, const bf16* A, const bf16* Bt, int M, int N, int K, const Epi& E, bool skip_ctx) {
    const int nN = N / 32, nM = M / 64, r = c.lane & 31, h = c.lane >> 5;
    for (int u = c.gw; u < nM * nN; u += c.NGW) {
        const int mt = u / nN, nt = u - mt * nN, row0 = mt * 64, col0 = nt * 32;
        if (skip_ctx && (row0 % TPB) < CTXL) continue;
        const bf16* a0 = A + (size_t)(row0 + r) * K + 8 * h; const bf16* a1 = a0 + (size_t)32 * K; const bf16* b0 = Bt + (size_t)(col0 + r) * K + 8 * h;
        f32x16 c0, c1;
#pragma unroll
        for (int i = 0; i < 16; ++i) { c0[i] = 0.f; c1[i] = 0.f; }
#pragma unroll 4
        for (int k = 0; k < K; k += 16) {
            const bf16x8 fa0 = *(const bf16x8*)(a0 + k), fa1 = *(const bf16x8*)(a1 + k), fb = *(const bf16x8*)(b0 + k);
            c0 = __builtin_amdgcn_mfma_f32_32x32x16_bf16(fa0, fb, c0, 0, 0, 0);
            c1 = __builtin_amdgcn_mfma_f32_32x32x16_bf16(fa1, fb, c1, 0, 0, 0);
        }
        E(c0, row0, col0 + r, h); E(c1, row0 + 32, col0 + r, h);
    }
}
struct EpiInProj { bf16* P; float* G;
    __device__ __forceinline__ void operator()(const f32x16& a, int row0, int col, int h) const {
#pragma unroll
        for (int i = 0; i < 16; ++i) { const int row = row0 + (i & 3) + 8 * (i >> 2) + 4 * h;
            if (col < NP) P[(size_t)row * NP + col] = (bf16)f2bf(a[i]); else G[(size_t)row * 32 + (col - NP)] = a[i]; } } };
struct EpiResid { const Ctx* c; const float* gate;
    __device__ __forceinline__ void operator()(const f32x16& a, int row0, int col, int h) const {
#pragma unroll
        for (int i = 0; i < 16; ++i) { const int row = row0 + (i & 3) + 8 * (i >> 2) + 4 * h;
            float* xr = xs_row(*c, row); const float gt = gate[(size_t)mod_row(row) * NMODC + col]; xr[col] += gt * a[i]; } } };
struct EpiRelu2 { bf16* H;
    __device__ __forceinline__ void operator()(const f32x16& a, int row0, int col, int h) const {
#pragma unroll
        for (int i = 0; i < 16; ++i) { const int row = row0 + (i & 3) + 8 * (i >> 2) + 4 * h; const float v = fmaxf(a[i], 0.f); H[(size_t)row * DFF + col] = (bf16)f2bf(v * v); } } };

__device__ __forceinline__ void attn_prep_phase(Ctx& c, int l) {
    const float* gq_b = c_in(12) + l * 64; const float* gk_b = c_in(13) + l * 64; const float* gq_c = c_in(14) + l * 64; const float* gk_c = c_in(15) + l * 64;
    for (int u = c.gw; u < NT * 12; u += c.NGW) {
        const int R = u / 12, j = u - R * 12; const int b = R / TPB, tp = R - b * TPB;
        const int jj = j < 6 ? j : j - 6; const bool isq = jj < 4;
        const int col = (j < 6 ? PC_B : PC_C) + 64 * jj + c.lane;
        const float* gn = j < 6 ? (isq ? gq_b : gk_b) : (isq ? gq_c : gk_c);
        bf16* p = c_P + (size_t)R * NP + col;
        const float x = bf2f(*p);
        const float ss = wave_sum(x * x);
        float y = x * rsqrtf(ss * (1.f / 64.f) + RMS_EPS) * gn[c.lane];
        if (tp >= CTXL) { const int t = tp - CTXL, d = c.lane; const int pos = d < 32 ? (t >> 6) : 32 + (t & 63); const int i = d & 15;
            const float cs = c_ROPE[2 * (pos * 16 + i)], sn = c_ROPE[2 * (pos * 16 + i) + 1];
            const float partner = __shfl_xor(y, 16);
            y = (d & 16) ? (y * cs + partner * sn) : (y * cs - partner * sn); }
        if (isq) y *= C2;
        *p = (bf16)f2bf(y);
    }
}

__device__ __forceinline__ void gdn_naive_unit(Ctx& c, int l, int u, LAS float* kq  ) {
    const int d = u & 1, h = (u >> 1) & 7, b = u >> 4, lane = c.lane;
    const float* cw = c_in(8) + (size_t)l * 5 * 1536;
    float wq[5], wk[5], wv[5];
#pragma unroll
    for (int j = 0; j < 5; ++j) { wq[j] = cw[j * 1536 + h * 64 + lane]; wk[j] = cw[j * 1536 + 512 + h * 64 + lane]; wv[j] = cw[j * 1536 + 1024 + h * 64 + lane]; }
    const float Aexp = __expf(c_in(9)[l * 16 + d * 8 + h]), dtb = c_in(10)[l * 16 + d * 8 + h];
    float S[64];
#pragma unroll
    for (int i = 0; i < 64; ++i) S[i] = 0.f;
    float* og = c_OG + (size_t)d * NT * 512;
    for (int seg = 0; seg < 2; ++seg) {
        const int len = seg ? SEQ : CTXL, base = b * TPB + (seg ? CTXL : 0);
        for (int i = 0; i < len; ++i) {
            const int t = d ? len - 1 - i : i; const int R = base + t;
            float qc = 0.f, kc = 0.f, vc = 0.f;
#pragma unroll
            for (int j = 0; j < 5; ++j) { const int tt = t + j - 2;
                if (tt >= 0 && tt < len) { const bf16* pr = c_P + (size_t)(base + tt) * NP + h * 64 + lane;
                    qc += wq[j] * bf2f(pr[0]); kc += wk[j] * bf2f(pr[512]); vc += wv[j] * bf2f(pr[1024]); } }
            qc = siluf(qc); kc = siluf(kc); vc = siluf(vc);
            const float q = qc * rsqrtf(wave_sum(qc * qc) + 1e-6f) * 0.125f, k = kc * rsqrtf(wave_sum(kc * kc) + 1e-6f);
            const float braw = c_Gt[(size_t)R * 32 + d * 8 + h], araw = c_Gt[(size_t)R * 32 + 16 + d * 8 + h] + dtb;
            const float beta = 1.f / (1.f + __expf(-braw));
            const float sp = araw > 20.f ? araw : log1pf(__expf(araw));
            const float a = __expf(-Aexp * sp);
            kq[lane] = k; kq[64 + lane] = q;
            LDS_WAIT(); asm volatile("" ::: "memory");
            float kS = 0.f;
#pragma unroll
            for (int i2 = 0; i2 < 64; ++i2) { S[i2] *= a; kS += kq[i2] * S[i2]; }
            const float vn = beta * (vc - kS);
            float o = 0.f;
#pragma unroll
            for (int i2 = 0; i2 < 64; ++i2) { S[i2] += kq[i2] * vn; o += kq[64 + i2] * S[i2]; }
            og[(size_t)R * 512 + h * 64 + lane] = o;
            LDS_WAIT(); asm volatile("" ::: "memory");
        }
    }
}

__device__ __forceinline__ void attn_naive_unit(Ctx& c, int l, int u, LAS float* sc  ) {
    const int typ = u & 1, hq = (u >> 1) & 3, R = u >> 3; const int lane = c.lane;
    const int b = R / TPB, tp = R - b * TPB; const bool isctx = tp < CTXL;
    if (isctx && l == NL - 1) return;
    const int pc = typ ? PC_C : PC_B, hkv = hq >> 1;
    const int tq = tp - CTXL;
    LAS float* qs = sc + 2304;
    qs[lane] = bf2f(c_P[(size_t)R * NP + pc + hq * 64 + lane]);
    LDS_WAIT(); asm volatile("" ::: "memory");
    float qv[64];
#pragma unroll
    for (int i = 0; i < 64; ++i) qv[i] = qs[i];
    int lo = CTXL, hi = CTXL;
    if (!isctx) { if (typ == 0) { lo = CTXL; hi = TPB; } else { lo = CTXL + (tq - 128 > 0 ? tq - 128 : 0); hi = CTXL + (tq + 128 < SEQ - 1 ? tq + 128 : SEQ - 1) + 1; } }
    const int nkA = CTXL, nkB = hi - lo, nk = nkA + nkB;
    const bf16* Kb = c_P + (size_t)b * TPB * NP + pc + 256 + hkv * 64;
    const bf16* Vb = Kb + 128;
    float mx = -INFINITY;
    for (int j0 = 0; j0 < nk; j0 += 64) {
        const int j = j0 + lane; float s = -INFINITY;
        if (j < nk) { const int kr = j < nkA ? j : lo + (j - nkA); const bf16x8* kp = (const bf16x8*)(Kb + (size_t)kr * NP); s = 0.f;
#pragma unroll
            for (int q8 = 0; q8 < 8; ++q8) { const bf16x8 kk = kp[q8];
#pragma unroll
                for (int e = 0; e < 8; ++e) s += qv[q8 * 8 + e] * bfs2f(kk[e]); } }
        sc[j] = s; mx = fmaxf(mx, s);
    }
    mx = wave_max(mx);
    float sinkl = 0.f;
    if (typ) { sinkl = c_in(16)[l * 4 + hq] * LOG2E; mx = fmaxf(mx, sinkl); }
    LDS_WAIT(); asm volatile("" ::: "memory");
    float lsum = 0.f;
    for (int j0 = 0; j0 < nk; j0 += 64) { const int j = j0 + lane; float p = 0.f; if (j < nk) p = exp2f(sc[j] - mx); sc[j] = p; lsum += p; }
    lsum = wave_sum(lsum);
    if (typ) lsum += exp2f(sinkl - mx);
    LDS_WAIT(); asm volatile("" ::: "memory");
    float o = 0.f;
    for (int j = 0; j < nkA; ++j) o += sc[j] * bf2f(Vb[(size_t)j * NP + lane]);
    for (int j = 0; j < nkB; ++j) o += sc[nkA + j] * bf2f(Vb[(size_t)(lo + j) * NP + lane]);
    c_ACT[(size_t)R * DM + 512 + typ * 256 + hq * 64 + lane] = (bf16)f2bf(o / lsum);
    LDS_WAIT(); asm volatile("" ::: "memory");
}
__device__ __forceinline__ void mixer_naive_phase(Ctx& c, int l) {
    LAS float* wl = (LAS float*)c.lds + c.wave * 2432;
    const bool gdn_wave = (c.wave == 0 && c.bx < 128);
    if (gdn_wave) { gdn_naive_unit(c, l, c.bx, wl); return; }
    const int aw = c.bx * NWAVES + c.wave - (c.bx < 128 ? c.bx + 1 : 128);
    const int NAW = c.G * NWAVES - (c.G < 128 ? c.G : 128);
    for (int u = aw; u < NT * 8; u += NAW) attn_naive_unit(c, l, u, wl);
}

__device__ __forceinline__ void gdn_combine_phase(Ctx& c, int l) {
    const float* gn = c_in(11) + l * 64;
    for (int u = c.gw; u < NT * GH; u += c.NGW) {
        const int R = u >> 3, h = u & 7; const int tp = R % TPB;
        if (l == NL - 1 && tp < CTXL) continue;
        const size_t o0 = (size_t)R * 512 + h * 64 + c.lane;
        const float o = c_OG[o0] + c_OG[(size_t)NT * 512 + o0];
        const float rstd = rsqrtf(wave_sum(o * o) * (1.f / 64.f) + RMS_EPS);
        const float z = bf2f(c_P[(size_t)R * NP + PC_Z + h * 64 + c.lane]);
        c_ACT[(size_t)R * DM + h * 64 + c.lane] = (bf16)f2bf(o * rstd * gn[c.lane] * siluf(z));
    }
}

__global__ void __launch_bounds__(NTHREADS, 2) mk_fwd(Args args) {
    extern __shared__ __attribute__((aligned(16))) unsigned char lds_raw[];
    Ctx c(args);
    c.lds = (LAS unsigned char*)lds_raw;
    c.tid = threadIdx.x; c.lane = c.tid & 63; c.wave = __builtin_amdgcn_readfirstlane(c.tid >> 6);
    c.G = gridDim.x; c.bx = blockIdx.x; c.gw = c.bx * NWAVES + c.wave; c.NGW = c.G * NWAVES;
    unsigned char* ws = args.ws;
    volatile LAS unsigned* MISC = (volatile LAS unsigned*)(c.lds + MISC_OFF);
    for (int u = c.tid; u < (LDS_BYTES - 131072) / 4; u += NTHREADS) ((LAS unsigned*)(c.lds + 131072))[u] = 0u;
    __syncthreads();
    const int lo = args.ph_lo, hi = args.ph_hi;
    XcdBarrier bar; bar.bar = (unsigned*)(ws + WS_CTL) + CW_BAR; bar.x = 0; bar.st = nullptr;
    if (hi - lo > 1) bar = xcd_barrier_post((unsigned*)(ws + WS_CTL) + CW_BAR, MISC + 8);

    for (int ph = lo; ph < hi; ++ph) {
        { int t_ = threadIdx.x; asm volatile("" : "+v"(t_)); c.tid = t_; c.lane = t_ & 63; c.wave = __builtin_amdgcn_readfirstlane(t_ >> 6); c.gw = c.bx * NWAVES + c.wave; }
#ifndef ONLY
#define ONLY -1
#endif
#define EN(k) (ONLY < 0 || ONLY == (k))
        if (ph == 0) {
            if (EN(10)) conv_weights(c, 0);
            __syncthreads();
            if (EN(11)) ada_mod_phase(c);
        } else {
            const int l = (ph - 1) / 9, s = (ph - 1) % 9;
            const float* modl = c_MOD + (size_t)l * 9 * NMODC;
            switch (s) {
            case 0: if (EN(0)) if (l > 0) { conv_weights(c, l); __syncthreads(); } norm_phase(c, l, 0); break;
            case 1: if (EN(1)) { EpiInProj E{c_P, c_Gt}; gemm_naive(c, c_ACT, c_Win_t, NT, DIN, DM, E, false); } break;
            case 2: if (EN(2)) attn_prep_phase(c, l); break;
            case 3: if (EN(3)) mixer_naive_phase(c, l); break;
            case 4: if (EN(4)) gdn_combine_phase(c, l); break;
            case 5: if (EN(5)) { EpiResid E{&c, modl + 2 * DM}; gemm_naive(c, c_ACT, c_Wout_t, NT, DM, DM, E, l == NL - 1); } break;
            case 6: if (EN(6)) norm_phase(c, l, 1); break;
            case 7: if (EN(7)) { EpiRelu2 E{c_H}; gemm_naive(c, c_ACT, c_W1_t, NT, DFF, DM, E, l == NL - 1); } break;
            case 8: if (EN(8)) { EpiResid E{&c, modl + 5 * DM}; gemm_naive(c, c_H, c_W2_t, NT, DM, DFF, E, l == NL - 1); } break;
            }
        }
        if (ph + 1 < hi) xcd_barrier(bar);
    }
}

extern "C" void kernel_launch(void* const* d_in, const int* in_sizes, int n_in, void* d_out, int out_size, void* d_ws, size_t ws_size, hipStream_t stream) {
    static int grid = 0;
    if (grid == 0) {
        if (n_in != 21 || out_size != NB * SEQ * DM || ws_size < WS_END) { fprintf(stderr, "kernel_launch: unexpected problem (n_in %d out %d ws %zu)\n", n_in, out_size, ws_size); grid = -1; return; }
        int dev = 0, cus = 0;
        if (hipGetDevice(&dev) != hipSuccess || hipDeviceGetAttribute(&cus, hipDeviceAttributeMultiprocessorCount, dev) != hipSuccess) { grid = -1; return; }
        if (hipFuncSetAttribute((const void*)mk_fwd, hipFuncAttributeMaxDynamicSharedMemorySize, LDS_BYTES) != hipSuccess) { fprintf(stderr, "kernel_launch: hipFuncSetAttribute failed\n"); grid = -1; return; }
        int per_cu = 0;
        if (hipOccupancyMaxActiveBlocksPerMultiprocessor(&per_cu, (const void*)mk_fwd, NTHREADS, LDS_BYTES) != hipSuccess || per_cu < 1) fprintf(stderr, "kernel_launch: occupancy query says %d\n", per_cu);
        (void)hipGetLastError();
        grid = cus;
    }
    if (grid < 0) return;
    if (hipMemsetAsync((char*)d_ws + WS_CTL, 0, CTL_ZERO_BYTES, stream) != hipSuccess) return;
    Args a{};
    for (int i = 0; i < 21; ++i) a.in[i] = (const float*)d_in[i];
    a.out = (float*)d_out; a.ws = (unsigned char*)d_ws;
#if MK_ONE_LAUNCH
    a.ph_lo = 0; a.ph_hi = NPHASES; a.li = 0;
    hipLaunchKernelGGL(mk_fwd, dim3(grid), dim3(NTHREADS), LDS_BYTES, stream, a);
#else
    for (int ph = 0; ph < NPHASES; ++ph) { a.ph_lo = ph; a.ph_hi = ph + 1; a.li = ph;
        hipLaunchKernelGGL(mk_fwd, dim3(grid), dim3(NTHREADS), LDS_BYTES, stream, a); }
#endif
}
```

```cpp
#include <hip/hip_runtime.h>
#include <cstdio>
#include <cstdint>

#define GAS __attribute__((address_space(1)))
#define LAS __attribute__((address_space(3)))
typedef unsigned short bf16;
typedef short bf16x8 __attribute__((ext_vector_type(8)));
typedef float f32x4 __attribute__((ext_vector_type(4)));
typedef float f32x16 __attribute__((ext_vector_type(16)));
typedef unsigned v4u __attribute__((ext_vector_type(4)));
typedef GAS unsigned gu32;
#define RLX_AGENT __ATOMIC_RELAXED, __HIP_MEMORY_SCOPE_AGENT
#define LDS_WAIT() asm volatile("s_waitcnt lgkmcnt(0)" ::: "memory")

#ifndef MK_ONE_LAUNCH
#define MK_ONE_LAUNCH 1
#endif
#ifndef MIXER_IN_MAIN
#define MIXER_IN_MAIN 1
#endif
constexpr int NWAVES = 8, NTHREADS = NWAVES * 64;

constexpr int DM = 1024, NB = 8, SEQ = 2048, CTXL = 256, TPB = SEQ + CTXL, NT = NB * TPB;
constexpr int NL = 2, DIN = 3104, NP = 3072, DFF = 4096, NMODC = 6 * DM;
constexpr int GH = 8;
constexpr float RMS_EPS = 1e-6f;
constexpr float C2 = 0.125f * 1.4426950408889634f;
constexpr float LOG2E = 1.4426950408889634f;
constexpr int PC_Z = 1536, PC_B = 2048, PC_C = 2560;
constexpr int NPHASES = 1 + 9 * NL;

constexpr size_t MiB = 1u << 20;
constexpr size_t WS_CTL = 0, CTL_ZERO_BYTES = 1 * MiB;
constexpr size_t WS_MOD = 1 * MiB;
constexpr size_t WS_ROPE = WS_MOD + 512 * 1024;
constexpr size_t WS_WIN = 2 * MiB;
constexpr size_t WS_WOUT = WS_WIN + (size_t)DIN * DM * 2 + 65536;
constexpr size_t WS_W1 = WS_WOUT + (size_t)DM * DM * 2;
constexpr size_t WS_W2 = WS_W1 + (size_t)DFF * DM * 2;
constexpr size_t WS_XSC = 27 * MiB;
constexpr size_t WS_ACT = 35 * MiB;
constexpr size_t WS_G = 71 * MiB;
constexpr size_t WS_P = 74 * MiB;
constexpr size_t WS_OG = 182 * MiB;
constexpr size_t WS_H = 74 * MiB;
constexpr size_t WS_END = 254 * MiB;
static_assert(WS_W2 + (size_t)DM * DFF * 2 <= WS_XSC, "weights");
static_assert(WS_H + (size_t)NT * DFF * 2 <= WS_END && WS_OG + (size_t)2 * NT * 512 * 4 <= WS_END, "ws map");
constexpr int CW_BAR = 4096;

constexpr int LDS_BYTES = 147456;
constexpr int MISC_OFF = 131072 + 320;

__device__ __forceinline__ unsigned f2bf(float f) { unsigned u = __builtin_bit_cast(unsigned, f); return (u + 0x7fffu + ((u >> 16) & 1u)) >> 16; }
__device__ __forceinline__ unsigned pk2(float lo, float hi) { return f2bf(lo) | (f2bf(hi) << 16); }
__device__ __forceinline__ float bf2f(bf16 v) { return __builtin_bit_cast(float, (unsigned)v << 16); }
__device__ __forceinline__ float bfs2f(short v) { return __builtin_bit_cast(float, ((unsigned)(unsigned short)v) << 16); }
__device__ __forceinline__ float lane_xor(float v, int o, int lane) { return __builtin_bit_cast(float, __builtin_amdgcn_ds_bpermute((lane ^ o) << 2, __builtin_bit_cast(int, v))); }
__device__ __forceinline__ float wave_sum_l(float v, int lane) {
#pragma unroll
    for (int o = 1; o < 64; o <<= 1) v += lane_xor(v, o, lane);
    return v;
}
__device__ __forceinline__ float wave_max_l(float v, int lane) {
#pragma unroll
    for (int o = 1; o < 64; o <<= 1) v = fmaxf(v, lane_xor(v, o, lane));
    return v;
}
#define wave_sum(v) wave_sum_l((v), c.lane)
#define wave_max(v) wave_max_l((v), c.lane)
__device__ __forceinline__ float siluf(float v) { return v / (1.f + __expf(-v)); }

#define XB_TMO      128
#define XB_XCNT(j)  (256  + 64 * (j))
#define XB_XSUB(j)  (1280 + 64 * (j))
#define XB_XGEN(j)  (2304 + 64 * (j))
#define XB_TOP      3328
#define XB_TOPGEN   3392
#define XCD_BAR_WORDS 3456
#define XB_SPIN_CAP (1u << 22)
__device__ __forceinline__ unsigned xb_ld(unsigned* p)              { return __hip_atomic_load(p, __ATOMIC_RELAXED, __HIP_MEMORY_SCOPE_AGENT); }
__device__ __forceinline__ unsigned xb_add(unsigned* p, unsigned v) { return __hip_atomic_fetch_add(p, v, __ATOMIC_RELAXED, __HIP_MEMORY_SCOPE_AGENT); }
__device__ __forceinline__ unsigned xb_xcc_id() { return (unsigned)__builtin_amdgcn_s_getreg((3 << 11) | 20) & 0xFu; }
#define XB_SPIN(cond, bar) do { unsigned _sp = 0; while (cond) { __builtin_amdgcn_s_sleep(1); \
    if ((++_sp & 255u) == 0u) { if (xb_ld(&(bar)[XB_TMO])) break; if (_sp > XB_SPIN_CAP) { atomicAdd(&(bar)[XB_TMO], 1u); break; } } } } while (0)
struct XcdBarrier { unsigned* bar; unsigned x; volatile LAS unsigned* st; };
__device__ __forceinline__ XcdBarrier xcd_barrier_post(unsigned* bar, volatile LAS unsigned* st, bool leader) {
    XcdBarrier b; b.bar = bar; b.x = xb_xcc_id(); b.st = st;
    if (leader) (void)xb_add(&bar[XB_XCNT(b.x)], 1u);
    return b;
}
__device__ __forceinline__ void xcd_barrier_complete(unsigned* bar, unsigned x, unsigned& nloc, unsigned& nx) {
    const unsigned G = gridDim.x * gridDim.y * gridDim.z;
    unsigned sum, cnt, mine, sp = 0u;
    for (;;) {
        sum = 0u; cnt = 0u; mine = 0u;
#pragma unroll 1
        for (unsigned j = 0; j < 16; ++j) { const unsigned c = xb_ld(&bar[XB_XCNT(j)]); sum += c; cnt += (c > 0u) ? 1u : 0u; mine = (j == x) ? c : mine; }
        if (sum == G) break;
        __builtin_amdgcn_s_sleep(1);
        if ((++sp & 255u) == 0u) { if (xb_ld(&bar[XB_TMO])) break; if (sp > XB_SPIN_CAP) { atomicAdd(&bar[XB_TMO], 1u); break; } }
    }
    nloc = mine > 0u ? mine : 1u; nx = cnt > 0u ? cnt : 1u;
}
__device__ __forceinline__ void xcd_barrier(const XcdBarrier& b, bool leader) {
    asm volatile("s_waitcnt vmcnt(0)" ::: "memory");
    __syncthreads();
    if (leader) {
        unsigned* bar = b.bar; asm volatile("" : "+s"(bar));
        __builtin_amdgcn_s_waitcnt(0);
        unsigned nloc = b.st[0], nx = b.st[1];
        if (nloc == 0u) { xcd_barrier_complete(bar, b.x, nloc, nx); b.st[0] = nloc; b.st[1] = nx; }
        const unsigned old = xb_add(&bar[XB_XSUB(b.x)], 1u);
        const unsigned gen = old / nloc;
        if (old + 1u == (gen + 1u) * nloc) {
            __builtin_amdgcn_fence(__ATOMIC_RELEASE, "agent");
            asm volatile("s_waitcnt vmcnt(0)" ::: "memory");
            const unsigned og = xb_add(&bar[XB_TOP], 1u);
            const unsigned tg = og / nx;
            if (og + 1u == (tg + 1u) * nx) xb_add(&bar[XB_TOPGEN], 1u);
            else XB_SPIN(xb_ld(&bar[XB_TOPGEN]) == tg, bar);
            __builtin_amdgcn_fence(__ATOMIC_ACQUIRE, "agent");
            xb_add(&bar[XB_XGEN(b.x)], 1u);
            asm volatile("s_waitcnt vmcnt(0)" ::: "memory");
        } else {
            XB_SPIN(xb_ld(&bar[XB_XGEN(b.x)]) == gen, bar);
            __builtin_amdgcn_fence(__ATOMIC_ACQUIRE, "agent");
            asm volatile("s_waitcnt vmcnt(0)" ::: "memory");
        }
    }
    __syncthreads();
}

struct Args { const float* in[21]; float* out; unsigned char* ws; int ph_lo, ph_hi, li, pad; };
struct Ctx {
    LAS unsigned char* lds;
    int tid, lane, wave, G, bx, gw, NGW;
    const __attribute__((address_space(4))) Args* A;
};
#define c_in(i)  (c.A->in[i])
#define c_out    (c.A->out)
#define c_Win_t  ((bf16*)(c.A->ws + WS_WIN))
#define c_Wout_t ((bf16*)(c.A->ws + WS_WOUT))
#define c_W1_t   ((bf16*)(c.A->ws + WS_W1))
#define c_W2_t   ((bf16*)(c.A->ws + WS_W2))
#define c_ACT    ((bf16*)(c.A->ws + WS_ACT))
#define c_P      ((bf16*)(c.A->ws + WS_P))
#define c_H      ((bf16*)(c.A->ws + WS_H))
#define c_XSC    ((float*)(c.A->ws + WS_XSC))
#define c_Gt     ((float*)(c.A->ws + WS_G))
#define c_OG     ((float*)(c.A->ws + WS_OG))
#define c_MOD    ((float*)(c.A->ws + WS_MOD))
#define c_ROPE   ((float*)(c.A->ws + WS_ROPE))
__device__ __forceinline__ float* xs_row(const Ctx& c, int R) {
    const int b = R / TPB, tp = R - b * TPB;
    return tp < CTXL ? c_XSC + ((size_t)(b * CTXL + tp) << 10) : c_out + ((size_t)(b * SEQ + tp - CTXL) << 10);
}
__device__ __forceinline__ const float* in_row(const Ctx& c, int R) {
    const int b = R / TPB, tp = R - b * TPB;
    return tp < CTXL ? c_in(2) + ((size_t)(b * CTXL + tp) << 10) : c_in(0) + ((size_t)(b * SEQ + tp - CTXL) << 10);
}
__device__ __forceinline__ int mod_row(int R) { const int b = R / TPB, tp = R - b * TPB; return tp < CTXL ? 8 : b; }

__device__ __forceinline__ void transpose_item(const float* W, int K, int N, bf16* WT, int k0, int n0, int n0d, LAS float* scr, int lane) {
#pragma unroll 8
    for (int i = 0; i < 32; ++i) { const int kk = 2 * i + (lane >> 5); scr[kk * 33 + (lane & 31)] = W[(size_t)(k0 + kk) * N + n0 + (lane & 31)]; }
    LDS_WAIT(); asm volatile("" ::: "memory");
    const int cch = lane & 7;
#pragma unroll
    for (int j = 0; j < 4; ++j) { const int n = (lane >> 3) + 8 * j; const LAS float* s = scr + (8 * cch) * 33 + n;
        v4u o; o.x = pk2(s[0 * 33], s[1 * 33]); o.y = pk2(s[2 * 33], s[3 * 33]); o.z = pk2(s[4 * 33], s[5 * 33]); o.w = pk2(s[6 * 33], s[7 * 33]);
        *(GAS v4u*)(WT + (size_t)(n0d + n) * K + k0 + 8 * cch) = o; }
    LDS_WAIT(); asm volatile("" ::: "memory");
}
__device__ __forceinline__ void conv_weights(Ctx& c, int l) {
    LAS float* scr = (LAS float*)(c.lds + c.wave * 16384);
    constexpr int I_IN = 16 * 97, I_O = 16 * 32, I_1 = 16 * 128, I_2 = 64 * 32, NITEMS = I_IN + I_O + I_1 + I_2;
    const float* w_in = c_in(7) + (size_t)l * DM * DIN; const float* w_out = c_in(17) + (size_t)l * DM * DM;
    const float* w1 = c_in(19) + (size_t)l * DM * DFF; const float* w2 = c_in(20) + (size_t)l * DFF * DM;
    for (int it = c.gw; it < NITEMS; it += c.NGW) {
        int r = it;
        if (r < I_IN) { const int kb = r / 97, nb = r % 97; const int nbd = nb < 64 ? nb : (nb == 64 ? 96 : nb - 1);
            transpose_item(w_in, DM, DIN, c_Win_t, 64 * kb, 32 * nb, 32 * nbd, scr, c.lane); continue; } r -= I_IN;
        if (r < I_O) { const int kb = r / 32, nb = r % 32; transpose_item(w_out, DM, DM, c_Wout_t, 64 * kb, 32 * nb, 32 * nb, scr, c.lane); continue; } r -= I_O;
        if (r < I_1) { const int kb = r / 128, nb = r % 128; transpose_item(w1, DM, DFF, c_W1_t, 64 * kb, 32 * nb, 32 * nb, scr, c.lane); continue; } r -= I_1;
        { const int kb = r / 32, nb = r % 32; transpose_item(w2, DFF, DM, c_W2_t, 64 * kb, 32 * nb, 32 * nb, scr, c.lane); }
    }
}
__device__ __forceinline__ void ada_mod_phase(Ctx& c) {
    LAS float* scond = (LAS float*)c.lds; LAS float* red = scond + 9 * 1024;
    if (c.bx < 192) {
        for (int i = c.tid; i < 9 * 1024; i += NTHREADS) { const int r = i >> 10, k = i & 1023; const float v = r < 8 ? c_in(1)[r * 1024 + k] : c_in(3)[k]; scond[i] = siluf(v); }
        __syncthreads();
        for (int u = c.bx; u < 192; u += c.G) {
            const int l = u / 96, cg = u % 96, col = cg * 64 + c.lane;
            const float* w = c_in(4) + (size_t)l * DM * NMODC + col;
            float acc[9];
#pragma unroll
            for (int r = 0; r < 9; ++r) acc[r] = 0.f;
            const int k0 = c.wave * 128;
#pragma unroll 4
            for (int k = k0; k < k0 + 128; ++k) { const float wv = w[(size_t)k * NMODC];
#pragma unroll
                for (int r = 0; r < 9; ++r) acc[r] += scond[r * 1024 + k] * wv; }
#pragma unroll
            for (int r = 0; r < 9; ++r) red[(c.wave * 9 + r) * 64 + c.lane] = acc[r];
            __syncthreads();
            for (int i = c.tid; i < 576; i += NTHREADS) { const int r = i >> 6, ln = i & 63; float s = 0.f;
#pragma unroll
                for (int w8 = 0; w8 < 8; ++w8) s += red[(w8 * 9 + r) * 64 + ln];
                const int cc = cg * 64 + ln; c_MOD[(size_t)(l * 9 + r) * NMODC + cc] = s + c_in(5)[l * NMODC + cc]; }
            __syncthreads();
        }
    }
    const int gid = c.bx * NTHREADS + c.tid;
    if (gid < 96 * 16) { const int pos = gid >> 4, i = gid & 15; const float inv = powf(10000.f, -(float)i / 16.f);
        const float p = (float)(pos < 32 ? pos : pos - 32); const float a = p * inv; c_ROPE[2 * gid] = cosf(a); c_ROPE[2 * gid + 1] = sinf(a); }
}

__device__ __forceinline__ void norm_phase(Ctx& c, int l, int which  ) {
    const float* g = (which == 0 ? c_in(6) : c_in(18)) + l * DM;
    const bool skip_ctx = (which == 1 && l == NL - 1);
    for (int R = c.gw; R < NT; R += c.NGW) {
        const int b = R / TPB, tp = R - b * TPB;
        if (skip_ctx && tp < CTXL) continue;
        const bool first = (l == 0 && which == 0);
        const float* src = first ? in_row(c, R) : xs_row(c, R);
        const f32x4* xr = (const f32x4*)src + c.lane;
        f32x4 v[4]; float ss = 0.f;
#pragma unroll
        for (int j = 0; j < 4; ++j) { v[j] = xr[64 * j]; ss += (v[j].x * v[j].x + v[j].y * v[j].y) + (v[j].z * v[j].z + v[j].w * v[j].w); }
        if (first) { f32x4* xo = (f32x4*)xs_row(c, R) + c.lane;
#pragma unroll
            for (int j = 0; j < 4; ++j) xo[64 * j] = v[j]; }
        const float rstd = rsqrtf(wave_sum(ss) * (1.f / DM) + RMS_EPS);
        const int rb = tp < CTXL ? 8 : b;
        const float* mrow = c_MOD + (size_t)(l * 9 + rb) * NMODC + (which == 0 ? 0 : 3 * DM);
        unsigned long long* o8 = (unsigned long long*)(c_ACT + (size_t)R * DM) + c.lane;
#pragma unroll
        for (int j = 0; j < 4; ++j) { const int col = 4 * c.lane + 256 * j;
            const f32x4 gg = *(const f32x4*)(g + col), sh = *(const f32x4*)(mrow + col), sc = *(const f32x4*)(mrow + DM + col);
            const float y0 = v[j].x * rstd * gg.x * (1.f + sc.x) + sh.x, y1 = v[j].y * rstd * gg.y * (1.f + sc.y) + sh.y;
            const float y2 = v[j].z * rstd * gg.z * (1.f + sc.z) + sh.z, y3 = v[j].w * rstd * gg.w * (1.f + sc.w) + sh.w;
            o8[64 * j] = (unsigned long long)pk2(y0, y1) | ((unsigned long long)pk2(y2, y3) << 32); }
    }
}

template <class Epi>
__device__ __forceinline__ void gemm_naive(const Ctx& c, const bf16* A, const bf16* Bt, int M, int N, int K, const Epi& E, bool skip_ctx) {
    const int nN = N / 32, nM = M / 64, r = c.lane & 31, h = c.lane >> 5;
    for (int u = c.gw; u < nM * nN; u += c.NGW) {
        const int mt = u / nN, nt = u - mt * nN, row0 = mt * 64, col0 = nt * 32;
        if (skip_ctx && (row0 % TPB) < CTXL) continue;
        const bf16* a0 = A + (size_t)(row0 + r) * K + 8 * h; const bf16* a1 = a0 + (size_t)32 * K; const bf16* b0 = Bt + (size_t)(col0 + r) * K + 8 * h;
        f32x16 c0, c1;
#pragma unroll
        for (int i = 0; i < 16; ++i) { c0[i] = 0.f; c1[i] = 0.f; }
#pragma unroll 4
        for (int k = 0; k < K; k += 16) {
            const bf16x8 fa0 = *(const bf16x8*)(a0 + k), fa1 = *(const bf16x8*)(a1 + k), fb = *(const bf16x8*)(b0 + k);
            c0 = __builtin_amdgcn_mfma_f32_32x32x16_bf16(fa0, fb, c0, 0, 0, 0);
            c1 = __builtin_amdgcn_mfma_f32_32x32x16_bf16(fa1, fb, c1, 0, 0, 0);
        }
        E(c0, row0, col0 + r, h); E(c1, row0 + 32, col0 + r, h);
    }
}
struct EpiInProj { bf16* P; float* G;
    __device__ __forceinline__ void operator()(const f32x16& a, int row0, int col, int h) const {
#pragma unroll
        for (int i = 0; i < 16; ++i) { const int row = row0 + (i & 3) + 8 * (i >> 2) + 4 * h;
            if (col < NP) P[(size_t)row * NP + col] = (bf16)f2bf(a[i]); else G[(size_t)row * 32 + (col - NP)] = a[i]; } } };
struct EpiGates { float* G;
    __device__ __forceinline__ void operator()(const f32x16& a, int row0, int col, int h) const {
#pragma unroll
        for (int i = 0; i < 16; ++i) { const int row = row0 + (i & 3) + 8 * (i >> 2) + 4 * h; G[(size_t)row * 32 + col] = a[i]; } } };
struct EpiResid { const Ctx* c; const float* gate;
    __device__ __forceinline__ void operator()(const f32x16& a, int row0, int col, int h) const {
#pragma unroll
        for (int i = 0; i < 16; ++i) { const int row = row0 + (i & 3) + 8 * (i >> 2) + 4 * h;
            float* xr = xs_row(*c, row); const float gt = gate[(size_t)mod_row(row) * NMODC + col]; xr[col] += gt * a[i]; } } };
struct EpiRelu2 { bf16* H;
    __device__ __forceinline__ void operator()(const f32x16& a, int row0, int col, int h) const {
#pragma unroll
        for (int i = 0; i < 16; ++i) { const int row = row0 + (i & 3) + 8 * (i >> 2) + 4 * h; const float v = fmaxf(a[i], 0.f); H[(size_t)row * DFF + col] = (bf16)f2bf(v * v); } } };

namespace pg8 {
#define PG8_LAS __attribute__((address_space(3)))
typedef unsigned short bf16_t;
typedef short bf16x8 __attribute__((ext_vector_type(8)));
typedef float f32x4 __attribute__((ext_vector_type(4)));
typedef unsigned u32x4 __attribute__((ext_vector_type(4)));
constexpr int BM = 256, BK = 64, HALF = 128, HTB = HALF * BK * 2  , STAGE_BYTES = 8 * HTB, NXCD = 8, WGM = 8;

__host__ __device__ __forceinline__ int lds_byte(int r, int c) { const int st = (r >> 4) * 2 + (c >> 5), rr = r & 15, cc = c & 31, ob = rr * 64 + cc * 2; return st * 1024 + (ob ^ (((ob >> 9) & 1) << 5)); }
__host__ __device__ __forceinline__ void stage_rc(int b, int& R, int& C) { const int st = b / 1024, sb = b % 1024, swz = sb ^ (((sb >> 9) & 1) << 5); R = (st >> 1) * 16 + swz / 64; C = (st & 1) * 32 + (swz % 64) / 2; }
__host__ __device__ __forceinline__ int perm32(int rho) { const int n = rho >> 4, i = rho & 15; return 8 * (i >> 2) + 4 * n + (i & 3); }

struct Unit { int pm, pn; };
struct Gemm { const bf16_t* A; const bf16_t* Bt; int M, N, K; };

struct StaticOrder {
    int nM, nN, nwg, G, c;
    __host__ __device__ void init(int M, int N, int G_, int c_) { nM = M / BM; nN = N / BM; nwg = nM * nN; G = G_; c = c_; }
    __host__ __device__ bool next(int i, Unit& u) const {
        const long L = (long)i * G + c; if (L >= nwg) return false;
        int wgid = (int)L; { const int q = nwg / NXCD, r = nwg % NXCD, xcd = wgid % NXCD, off = wgid / NXCD; wgid = (xcd < r ? xcd * (q + 1) : r * (q + 1) + (xcd - r) * q) + off; }
        const int nig = WGM * nN, gid = wgid / nig, fm = gid * WGM, gsz = (nM - fm) < WGM ? (nM - fm) : WGM;
        u.pm = fm + ((wgid % nig) % gsz); u.pn = (wgid % nig) / gsz; return true;
    }
    __device__ __forceinline__ void a_ready(const Unit&) const {}
    __device__ __forceinline__ void done(const Unit&) const {}
};

__device__ __forceinline__ unsigned cvt_pk_bf16(float lo, float hi) { unsigned r; asm volatile("v_cvt_pk_bf16_f32 %0, %1, %2" : "=v"(r) : "v"(lo), "v"(hi)); return r; }
template <int ACT  > struct EpiBf16 {
    static constexpr bool PERM = true, AFTER_DRAIN = false; static_assert(ACT == 0 || ACT == 2, "EpiBf16: ACT is 0 (none) or 2 (squared relu)");
    bf16_t* O; int ldc; const float* bias; int split_cols; size_t split_stride; float scale0;
    __device__ __forceinline__ void operator()(const f32x4 (&acc)[2][2][4][2], const Unit& u, int wr, int wc, int fr, int fq) const {
        const int row0 = u.pm * BM + wr * 64 + fr; int colt = u.pn * BM; bf16_t* base = O;
        float sc = 1.f; if (split_cols) { const int t = colt / split_cols; base += (size_t)t * split_stride; colt -= t * split_cols; if (t == 0) sc = scale0; }
        const int col0 = colt + wc * 32 + 8 * fq, bcol0 = u.pn * BM + wc * 32 + 8 * fq;
        f32x4 bv[2][2];
#pragma unroll
        for (int bj = 0; bj < 2; ++bj)
#pragma unroll
            for (int n = 0; n < 2; ++n) bv[bj][n] = bias ? *(const f32x4*)(bias + bcol0 + bj * HALF + 4 * n) : (f32x4){0.f, 0.f, 0.f, 0.f};
#pragma unroll
        for (int ai = 0; ai < 2; ++ai)
#pragma unroll
            for (int m = 0; m < 4; ++m) { bf16_t* rowp = base + (size_t)(row0 + ai * HALF + m * 16) * ldc + col0;
#pragma unroll
                for (int bj = 0; bj < 2; ++bj) { f32x4 v0 = acc[ai][bj][m][0] + bv[bj][0], v1 = acc[ai][bj][m][1] + bv[bj][1];
                    if (ACT == 2) { v0 = __builtin_elementwise_max(v0, (f32x4){0.f, 0.f, 0.f, 0.f}); v1 = __builtin_elementwise_max(v1, (f32x4){0.f, 0.f, 0.f, 0.f}); v0 = v0 * v0; v1 = v1 * v1; }
                    v0 = v0 * sc; v1 = v1 * sc; u32x4 w; w.x = cvt_pk_bf16(v0[0], v0[1]); w.y = cvt_pk_bf16(v0[2], v0[3]); w.z = cvt_pk_bf16(v1[0], v1[1]); w.w = cvt_pk_bf16(v1[2], v1[3]);
                    *(u32x4*)(rowp + bj * HALF) = w; } }
    }
};

struct EpiGateRes {
    static constexpr bool PERM = false, AFTER_DRAIN = false;
    float* xsc; float* out; const float* gate;
    __device__ __forceinline__ void operator()(const f32x4 (&acc)[2][2][4][2], const Unit& u, int wr, int wc, int fr, int fq) const {
        const int b = u.pm / 9, seg = u.pm - 9 * b;
        float* base = seg == 0 ? xsc + ((size_t)(b * 256) << 10) : out + ((size_t)(b * 2048 + (seg - 1) * 256) << 10);
        const float* grow = gate + (size_t)(seg == 0 ? 8 : b) * 6144;
        const int col0 = u.pn * BM + wc * 32 + 4 * fq;
        f32x4 gv[2][2];
#pragma unroll
        for (int bj = 0; bj < 2; ++bj)
#pragma unroll
            for (int n = 0; n < 2; ++n) gv[bj][n] = *(const f32x4*)(grow + col0 + bj * HALF + n * 16);
#pragma unroll
        for (int ai = 0; ai < 2; ++ai)
#pragma unroll
            for (int m = 0; m < 4; ++m) { float* rowp = base + (size_t)(ai * HALF + wr * 64 + m * 16 + fr) * 1024 + col0;
#pragma unroll
                for (int bj = 0; bj < 2; ++bj)
#pragma unroll
                    for (int n = 0; n < 2; ++n) { f32x4* p = (f32x4*)(rowp + bj * HALF + n * 16); *p = *p + gv[bj][n] * acc[ai][bj][m][n]; }
                if (m & 1) asm volatile("" ::: "memory"); }
    }
};
struct RowOrder {
    StaticOrder so; bool lat_only;
    __device__ void init(int N, int G_, int c_, bool lat) { lat_only = lat; so.init(lat ? 16384 : 18432, N, G_, c_); }
    __device__ bool next(int i, Unit& u) const { if (!so.next(i, u)) return false; if (lat_only) u.pm = 9 * (u.pm >> 3) + 1 + (u.pm & 7); return true; }
    __device__ __forceinline__ void a_ready(const Unit&) const {}
    __device__ __forceinline__ void done(const Unit&) const {}
};
template <class Epi, class Sched, bool ALIGN_EPI = false, bool SP2 = false>
__device__ __forceinline__ void gemm_phase(PG8_LAS unsigned char* lds, const Gemm g, const Sched& S, const Epi& E, const int tid) {
    const int wid = __builtin_amdgcn_readfirstlane(tid >> 6), lane = tid & 63, wr = wid >> 2, wc = wid & 3, fr = lane & 15, fq = lane >> 4;
    const int K = g.K, nt = K / BK;
    unsigned voffA[2], voffB[2];
#pragma unroll
    for (int i = 0; i < 2; ++i) { int R, C; stage_rc(tid * 16 + i * 8192, R, C); const int Rb = Epi::PERM ? ((R & ~31) + perm32(R & 31)) : R;
        voffA[i] = (unsigned)(R * K + C) * 2u; voffB[i] = (unsigned)(Rb * K + C) * 2u; }
    const size_t kstep = (size_t)(BK * 2);
    const size_t hstep = (size_t)HALF * K * 2;
    const size_t tstep = 2 * hstep;
    const unsigned ldsw = (unsigned)wid * 1024u;
    const int aoff = lds_byte(wr * 64 + fr, fq * 8), boff = lds_byte(wc * 32 + fr, fq * 8);
#define PG8_SA(b, h) (((b) * 2 + (h)) * HTB)
#define PG8_SB(b, h) ((4 + (b) * 2 + (h)) * HTB)
#define PG8_STAGE(bufoff, gbase, voff) do { _Pragma("unroll") for (int _i = 0; _i < 2; ++_i) \
        __builtin_amdgcn_global_load_lds((const unsigned*)((const char*)(gbase) + (voff)[_i]), (PG8_LAS unsigned*)(lds + (bufoff) + ldsw + _i * 8192), 16, 0, 0); } while (0)
#define PG8_LDA(dst, b, h) do { _Pragma("unroll") for (int m = 0; m < 4; ++m) _Pragma("unroll") for (int k = 0; k < 2; ++k) dst[m][k] = *(const PG8_LAS bf16x8*)(lds + PG8_SA(b, h) + aoff + m * 2048 + k * 1024); } while (0)
#define PG8_LDB(dst, b, h) do { _Pragma("unroll") for (int n = 0; n < 2; ++n) _Pragma("unroll") for (int k = 0; k < 2; ++k) dst[n][k] = *(const PG8_LAS bf16x8*)(lds + PG8_SB(b, h) + boff + n * 2048 + k * 1024); } while (0)
#define PG8_MMA(ai, bj, At, Bt) do { __builtin_amdgcn_s_setprio(1); _Pragma("unroll") for (int m = 0; m < 4; ++m) _Pragma("unroll") for (int n = 0; n < 2; ++n) _Pragma("unroll") for (int k = 0; k < 2; ++k) \
        acc[ai][bj][m][n] = __builtin_amdgcn_mfma_f32_16x16x32_bf16(Bt[n][k], At[m][k], acc[ai][bj][m][n], 0, 0, 0); __builtin_amdgcn_s_setprio(0); } while (0)
#define PG8_WAIT_V(n) asm volatile("s_waitcnt vmcnt(" #n ")" ::: "memory")
#define PG8_WAIT_L(n) asm volatile("s_waitcnt lgkmcnt(" #n ")" ::: "memory")
#define PG8_BAR __builtin_amdgcn_s_barrier()
#define PG8_SCHED __builtin_amdgcn_sched_barrier(0)
    Unit cur, nxt; int ui = 0;
    if (!S.next(0, cur)) return;
    f32x4 acc[2][2][4][2];
#pragma unroll
    for (int a = 0; a < 2; ++a)
#pragma unroll
        for (int b = 0; b < 2; ++b)
#pragma unroll
            for (int m = 0; m < 4; ++m)
#pragma unroll
                for (int n = 0; n < 2; ++n) acc[a][b][m][n] = (f32x4){0.f, 0.f, 0.f, 0.f};
    bf16x8 At[4][2], B0[2][2], B1[2][2];
    const char* cA = (const char*)g.A + (size_t)cur.pm * tstep; const char* cB = (const char*)g.Bt + (size_t)cur.pn * tstep;
    S.a_ready(cur);
    if constexpr (SP2) {
        PG8_STAGE(PG8_SB(0, 0), cB, voffB); PG8_STAGE(PG8_SB(0, 1), cB + hstep, voffB); PG8_STAGE(PG8_SA(0, 0), cA, voffA); PG8_STAGE(PG8_SA(0, 1), cA + hstep, voffA);
        if (wr == 1) PG8_BAR;
        PG8_WAIT_V(2); PG8_BAR;
        PG8_STAGE(PG8_SB(1, 0), cB + kstep, voffB); PG8_STAGE(PG8_SA(1, 0), cA + kstep, voffA); PG8_STAGE(PG8_SB(1, 1), cB + hstep + kstep, voffB);
        PG8_WAIT_V(6); PG8_BAR;
    } else {
        PG8_STAGE(PG8_SB(0, 0), cB, voffB); PG8_STAGE(PG8_SA(0, 0), cA, voffA); PG8_STAGE(PG8_SB(0, 1), cB + hstep, voffB); PG8_STAGE(PG8_SA(0, 1), cA + hstep, voffA);
        if (wr == 1) PG8_BAR;
        PG8_WAIT_V(4); PG8_BAR;
        PG8_STAGE(PG8_SB(1, 0), cB + kstep, voffB); PG8_STAGE(PG8_SA(1, 0), cA + kstep, voffA); PG8_STAGE(PG8_SB(1, 1), cB + hstep + kstep, voffB);
        PG8_WAIT_V(6); PG8_BAR;
    }
    for (;;) {
        const bool has_next = S.next(ui + 1, nxt);
        const char* nA = has_next ? (const char*)g.A + (size_t)nxt.pm * tstep : cA; const char* nB = has_next ? (const char*)g.Bt + (size_t)nxt.pn * tstep : cB;
        for (int t = 0; t < nt; t += 2) {
            const bool last = (t == nt - 2);
            const char* a1 = cA + (size_t)(t + 1) * kstep;
            const char* a2 = last ? nA : cA + (size_t)(t + 2) * kstep; const char* b2 = last ? nB : cB + (size_t)(t + 2) * kstep;
            const char* a3 = a2 + kstep; const char* b3 = b2 + kstep;
            if (last && has_next) S.a_ready(nxt);
            if constexpr (SP2) {
            PG8_LDB(B0, 0, 0); PG8_LDB(B1, 0, 1); PG8_SCHED; PG8_LDA(At, 0, 0); PG8_STAGE(PG8_SA(1, 1), a1 + hstep, voffA);
            PG8_WAIT_V(8); PG8_WAIT_L(0); PG8_BAR; PG8_MMA(0, 0, At, B0); PG8_MMA(0, 1, At, B1); PG8_BAR; PG8_SCHED;
            PG8_LDA(At, 0, 1); PG8_STAGE(PG8_SB(0, 0), b2, voffB); PG8_STAGE(PG8_SB(0, 1), b2 + hstep, voffB); PG8_STAGE(PG8_SA(0, 0), a2, voffA);
            PG8_WAIT_V(8); PG8_WAIT_L(0); PG8_BAR; PG8_MMA(1, 0, At, B0); PG8_MMA(1, 1, At, B1); PG8_BAR; PG8_SCHED;
            PG8_LDB(B0, 1, 0); PG8_LDB(B1, 1, 1); PG8_SCHED; PG8_LDA(At, 1, 0); PG8_STAGE(PG8_SA(0, 1), a2 + hstep, voffA);
            PG8_WAIT_V(8); PG8_WAIT_L(0); PG8_BAR; PG8_MMA(0, 0, At, B0); PG8_MMA(0, 1, At, B1); PG8_BAR; PG8_SCHED;
            PG8_LDA(At, 1, 1); PG8_STAGE(PG8_SB(1, 0), b3, voffB); PG8_STAGE(PG8_SB(1, 1), b3 + hstep, voffB); PG8_STAGE(PG8_SA(1, 0), a3, voffA);
            PG8_WAIT_V(8); PG8_WAIT_L(0); PG8_BAR; PG8_MMA(1, 0, At, B0); PG8_MMA(1, 1, At, B1); PG8_BAR; PG8_SCHED;
            } else {
            PG8_LDB(B0, 0, 0); PG8_SCHED; PG8_LDA(At, 0, 0); PG8_STAGE(PG8_SA(1, 1), a1 + hstep, voffA);
            PG8_WAIT_L(8); PG8_BAR; PG8_WAIT_L(0); PG8_MMA(0, 0, At, B0); PG8_BAR; PG8_SCHED;
            PG8_LDB(B1, 0, 1); PG8_STAGE(PG8_SB(0, 0), b2, voffB);
            PG8_BAR; PG8_WAIT_L(0); PG8_MMA(0, 1, At, B1); PG8_BAR;
            PG8_LDA(At, 0, 1); PG8_STAGE(PG8_SA(0, 0), a2, voffA);
            PG8_BAR; PG8_WAIT_L(0); PG8_MMA(1, 0, At, B0); PG8_BAR; PG8_SCHED;
            PG8_STAGE(PG8_SB(0, 1), b2 + hstep, voffB);
            PG8_WAIT_V(6); PG8_BAR; PG8_MMA(1, 1, At, B1); PG8_BAR;
            PG8_LDB(B0, 1, 0); PG8_SCHED; PG8_LDA(At, 1, 0); PG8_STAGE(PG8_SA(0, 1), a2 + hstep, voffA);
            PG8_WAIT_L(8); PG8_BAR; PG8_WAIT_L(0); PG8_MMA(0, 0, At, B0); PG8_BAR; PG8_SCHED;
            PG8_LDB(B1, 1, 1); PG8_STAGE(PG8_SB(1, 0), b3, voffB);
            PG8_BAR; PG8_WAIT_L(0); PG8_MMA(0, 1, At, B1); PG8_BAR;
            PG8_LDA(At, 1, 1); PG8_STAGE(PG8_SA(1, 0), a3, voffA);
            PG8_BAR; PG8_WAIT_L(0); PG8_MMA(1, 0, At, B0); PG8_BAR; PG8_SCHED;
            PG8_STAGE(PG8_SB(1, 1), b3 + hstep, voffB);
            PG8_WAIT_V(6); PG8_BAR; PG8_MMA(1, 1, At, B1); PG8_BAR;
            }
        }
        if constexpr (ALIGN_EPI) { if (wr == 0) PG8_BAR; }
        if constexpr (!Epi::AFTER_DRAIN) { E(acc, cur, wr, wc, fr, fq); S.done(cur); }
        if (!has_next) break;
#pragma unroll
        for (int a = 0; a < 2; ++a)
#pragma unroll
            for (int b = 0; b < 2; ++b)
#pragma unroll
                for (int m = 0; m < 4; ++m)
#pragma unroll
                    for (int n = 0; n < 2; ++n) acc[a][b][m][n] = (f32x4){0.f, 0.f, 0.f, 0.f};
        cur = nxt; cA = nA; cB = nB; ++ui;
        if constexpr (ALIGN_EPI) { if (wr == 1) PG8_BAR; }
    }
    PG8_WAIT_V(0);
    if constexpr (!ALIGN_EPI) { if (wr == 0) PG8_BAR; }
    PG8_BAR;
    if constexpr (Epi::AFTER_DRAIN) { E.fused(acc, cur, wr, wc, fr, fq, lds, wid, lane); S.done(cur); }
#undef PG8_SA
#undef PG8_SB
#undef PG8_STAGE
#undef PG8_LDA
#undef PG8_LDB
#undef PG8_MMA
#undef PG8_WAIT_V
#undef PG8_WAIT_L
#undef PG8_BAR
#undef PG8_SCHED
}
}

__device__ __forceinline__ void attn_prep_phase(Ctx& c, int l) {
    const float* gq_b = c_in(12) + l * 64; const float* gk_b = c_in(13) + l * 64; const float* gq_c = c_in(14) + l * 64; const float* gk_c = c_in(15) + l * 64;
    for (int u = c.gw; u < NT * 12; u += c.NGW) {
        const int R = u / 12, j = u - R * 12; const int b = R / TPB, tp = R - b * TPB;
        const int jj = j < 6 ? j : j - 6; const bool isq = jj < 4;
        const int col = (j < 6 ? PC_B : PC_C) + 64 * jj + c.lane;
        const float* gn = j < 6 ? (isq ? gq_b : gk_b) : (isq ? gq_c : gk_c);
        bf16* p = c_P + (size_t)R * NP + col;
        const float x = bf2f(*p);
        const float ss = wave_sum(x * x);
        float y = x * rsqrtf(ss * (1.f / 64.f) + RMS_EPS) * gn[c.lane];
        if (tp >= CTXL) { const int t = tp - CTXL, d = c.lane; const int pos = d < 32 ? (t >> 6) : 32 + (t & 63); const int i = d & 15;
            const float cs = c_ROPE[2 * (pos * 16 + i)], sn = c_ROPE[2 * (pos * 16 + i) + 1];
            const float partner = lane_xor(y, 16, c.lane);
            y = (d & 16) ? (y * cs + partner * sn) : (y * cs - partner * sn); }
        if (isq) y *= C2;
        *p = (bf16)f2bf(y);
    }
}

__device__ __forceinline__ void gdn_naive_unit(Ctx& c, int l, int u, LAS float* kq  ) {
    const int d = u & 1, h = (u >> 1) & 7, b = u >> 4, lane = c.lane;
    const float* cw = c_in(8) + (size_t)l * 5 * 1536;
    LAS float* wts = kq + 128;
#pragma unroll
    for (int j = 0; j < 5; ++j) { wts[(3 * j) * 64 + lane] = cw[j * 1536 + h * 64 + lane]; wts[(3 * j + 1) * 64 + lane] = cw[j * 1536 + 512 + h * 64 + lane]; wts[(3 * j + 2) * 64 + lane] = cw[j * 1536 + 1024 + h * 64 + lane]; }
    LDS_WAIT(); asm volatile("" ::: "memory");
    const float Aexp = __expf(c_in(9)[l * 16 + d * 8 + h]), dtb = c_in(10)[l * 16 + d * 8 + h];
    float S[64];
#pragma unroll
    for (int i = 0; i < 64; ++i) S[i] = 0.f;
    float* og = c_OG + (size_t)d * NT * 512;
    for (int seg = 0; seg < 2; ++seg) {
        const int len = seg ? SEQ : CTXL, base = b * TPB + (seg ? CTXL : 0);
        for (int i = 0; i < len; ++i) {
            const int t = d ? len - 1 - i : i; const int R = base + t;
            float qc = 0.f, kc = 0.f, vc = 0.f;
#pragma unroll
            for (int j = 0; j < 5; ++j) { const int tt = t + j - 2;
                if (tt >= 0 && tt < len) { const bf16* pr = c_P + (size_t)(base + tt) * NP + h * 64 + lane;
                    qc += wts[(3 * j) * 64 + lane] * bf2f(pr[0]); kc += wts[(3 * j + 1) * 64 + lane] * bf2f(pr[512]); vc += wts[(3 * j + 2) * 64 + lane] * bf2f(pr[1024]); } }
            qc = siluf(qc); kc = siluf(kc); vc = siluf(vc);
            const float q = qc * rsqrtf(wave_sum(qc * qc) + 1e-6f) * 0.125f, k = kc * rsqrtf(wave_sum(kc * kc) + 1e-6f);
            const float braw = c_Gt[(size_t)R * 32 + d * 8 + h], araw = c_Gt[(size_t)R * 32 + 16 + d * 8 + h] + dtb;
            const float beta = 1.f / (1.f + __expf(-braw));
            const float sp = araw > 20.f ? araw : log1pf(__expf(araw));
            const float a = __expf(-Aexp * sp);
            kq[lane] = k; kq[64 + lane] = q;
            LDS_WAIT(); asm volatile("" ::: "memory");
            float kS = 0.f;
#pragma unroll
            for (int i2 = 0; i2 < 64; ++i2) { S[i2] *= a; kS += kq[i2] * S[i2]; }
            const float vn = beta * (vc - kS);
            float o = 0.f;
#pragma unroll
            for (int i2 = 0; i2 < 64; ++i2) { S[i2] += kq[i2] * vn; o += kq[64 + i2] * S[i2]; }
            og[(size_t)R * 512 + h * 64 + lane] = o;
            LDS_WAIT(); asm volatile("" ::: "memory");
        }
    }
}

__device__ __forceinline__ void attn_naive_unit(Ctx& c, int l, int u, LAS float* sc  ) {
    const int typ = u & 1, hq = (u >> 1) & 3, R = u >> 3; const int lane = c.lane;
    const int b = R / TPB, tp = R - b * TPB; const bool isctx = tp < CTXL;
    if (isctx && l == NL - 1) return;
    const int pc = typ ? PC_C : PC_B, hkv = hq >> 1;
    const int tq = tp - CTXL;
    LAS float* qs = sc + 2304;
    qs[lane] = bf2f(c_P[(size_t)R * NP + pc + hq * 64 + lane]);
    LDS_WAIT(); asm volatile("" ::: "memory");
    float qv[64];
#pragma unroll
    for (int i = 0; i < 64; ++i) qv[i] = qs[i];
    int lo = CTXL, hi = CTXL;
    if (!isctx) { if (typ == 0) { lo = CTXL; hi = TPB; } else { lo = CTXL + (tq - 128 > 0 ? tq - 128 : 0); hi = CTXL + (tq + 128 < SEQ - 1 ? tq + 128 : SEQ - 1) + 1; } }
    const int nkA = CTXL, nkB = hi - lo, nk = nkA + nkB;
    const bf16* Kb = c_P + (size_t)b * TPB * NP + pc + 256 + hkv * 64;
    const bf16* Vb = Kb + 128;
    float mx = -INFINITY;
    for (int j0 = 0; j0 < nk; j0 += 64) {
        const int j = j0 + lane; float s = -INFINITY;
        if (j < nk) { const int kr = j < nkA ? j : lo + (j - nkA); const bf16x8* kp = (const bf16x8*)(Kb + (size_t)kr * NP); s = 0.f;
#pragma unroll
            for (int q8 = 0; q8 < 8; ++q8) { const bf16x8 kk = kp[q8];
#pragma unroll
                for (int e = 0; e < 8; ++e) s += qv[q8 * 8 + e] * bfs2f(kk[e]); } }
        sc[j] = s; mx = fmaxf(mx, s);
    }
    mx = wave_max(mx);
    float sinkl = 0.f;
    if (typ) { sinkl = c_in(16)[l * 4 + hq] * LOG2E; mx = fmaxf(mx, sinkl); }
    LDS_WAIT(); asm volatile("" ::: "memory");
    float lsum = 0.f;
    for (int j0 = 0; j0 < nk; j0 += 64) { const int j = j0 + lane; float p = 0.f; if (j < nk) p = exp2f(sc[j] - mx); sc[j] = p; lsum += p; }
    lsum = wave_sum(lsum);
    if (typ) lsum += exp2f(sinkl - mx);
    LDS_WAIT(); asm volatile("" ::: "memory");
    float o = 0.f;
    for (int j = 0; j < nkA; ++j) o += sc[j] * bf2f(Vb[(size_t)j * NP + lane]);
    for (int j = 0; j < nkB; ++j) o += sc[nkA + j] * bf2f(Vb[(size_t)(lo + j) * NP + lane]);
    c_ACT[(size_t)R * DM + 512 + typ * 256 + hq * 64 + lane] = (bf16)f2bf(o / lsum);
    LDS_WAIT(); asm volatile("" ::: "memory");
}
__device__ __forceinline__ void mixer_naive_phase(Ctx& c, int l) {
    LAS float* wl = (LAS float*)c.lds + c.wave * 2432;
    const bool gdn_wave = (c.wave == 0 && c.bx < 128);
    if (gdn_wave) { gdn_naive_unit(c, l, c.bx, wl); return; }
    const int aw = c.bx * NWAVES + c.wave - (c.bx < 128 ? c.bx + 1 : 128);
    const int NAW = c.G * NWAVES - (c.G < 128 ? c.G : 128);
    for (int u = aw; u < NT * 8; u += NAW) attn_naive_unit(c, l, u, wl);
}

#ifndef ATTN_STORE16
#define ATTN_STORE16(p,v) (*(u32x4*)(p)=(v))
#endif
namespace attn_body {
using bf16=unsigned short;
using bf16x8=__attribute__((ext_vector_type(8)))short;
using s16x4=__attribute__((ext_vector_type(4)))short;
using f32x16=__attribute__((ext_vector_type(16)))float;
using u32x4=__attribute__((ext_vector_type(4)))unsigned;
constexpr int D=64,QP=3072,OP=1024;
constexpr int NW=8,QBLK=32,QB=QBLK*NW,KVBLK=64;
__device__ __forceinline__ int crow(int r,int hi){return (r&3)+8*(r>>2)+4*hi;}
#define SBAR() __builtin_amdgcn_sched_barrier(0)
__device__ __forceinline__ void wmask(f32x16&p0,f32x16&p1,int rel,int hi){
  const float NEG=-INFINITY; const int kb=rel+4*hi;
  #pragma unroll
  for(int r=0;r<16;++r){const int kv=kb+(r&3)+8*(r>>2); if(kv>128||kv<-128)p0[r]=NEG; if(kv+32>128||kv+32<-128)p1[r]=NEG;}
}

constexpr int NSLOT=3, SLOTB=8192;
constexpr int LDS_K=0, LDS_V=NSLOT*SLOTB, LDS_WS=2*NSLOT*SLOTB, LDS_OST=LDS_WS+NW*64*4, LDS_BYTES=LDS_OST+NW*4096;
constexpr float C2=0.125f*1.4426950408889634f;
__device__ __forceinline__ void glds16(const void*gsrc,unsigned lds_dst){unsigned keep;
  asm volatile("s_mov_b32 %0, m0\n\ts_mov_b32 m0, %2\n\ts_nop 0\n\tglobal_load_lds_dwordx4 %1, off\n\ts_mov_b32 m0, %0":"=&s"(keep):"v"(gsrc),"s"(lds_dst):"memory");}
__device__ __forceinline__ float max3f(float a,float b,float c){float r;asm("v_max3_f32 %0, %1, %2, %3":"=v"(r):"v"(a),"v"(b),"v"(c));return r;}
__device__ __forceinline__ float max2f(float a,float b){float r;asm("v_max_f32_e32 %0, %1, %2":"=v"(r):"v"(a),"v"(b));return r;}
__device__ __forceinline__ float fadd_s(float a,float b){float r;asm("v_add_f32_e32 %0, %1, %2":"=v"(r):"v"(a),"v"(b));return r;}
__device__ __forceinline__ float fsub_s(float a,float b){float r;asm("v_sub_f32_e32 %0, %1, %2":"=v"(r):"v"(a),"v"(b));return r;}
typedef float f32x2_t __attribute__((ext_vector_type(2))); typedef __bf16 bf16x2_t __attribute__((ext_vector_type(2)));
__device__ __forceinline__ unsigned cvtpk_s(float lo,float hi){f32x2_t v={lo,hi};bf16x2_t b=__builtin_convertvector(v,bf16x2_t);return __builtin_bit_cast(unsigned,b);}
#define WAIT_BAR(N) asm volatile("s_waitcnt vmcnt(" #N ") lgkmcnt(0)\n\ts_barrier":::"memory")

__device__ __forceinline__ void qkt(f32x16&p0,f32x16&p1,const char*Kslot,const bf16x8*qr,const f32x16&negm,int r32,int hi){
  const char*kb=Kslot+hi*1024+r32*16;
  #pragma unroll
  for(int d0=0;d0<4;++d0){
    const bf16x8 b0=*reinterpret_cast<const bf16x8*>(kb+d0*2048);
    const bf16x8 b1=*reinterpret_cast<const bf16x8*>(kb+d0*2048+512);
    if(d0==0){p0=__builtin_amdgcn_mfma_f32_32x32x16_bf16(b0,qr[0],negm,0,0,0);p1=__builtin_amdgcn_mfma_f32_32x32x16_bf16(b1,qr[0],negm,0,0,0);}
    else{p0=__builtin_amdgcn_mfma_f32_32x32x16_bf16(b0,qr[d0],p0,0,0,0);p1=__builtin_amdgcn_mfma_f32_32x32x16_bf16(b1,qr[d0],p1,0,0,0);}}
}
typedef __attribute__((address_space(3))) const char* lds_cptr;
typedef short v4i16_t __attribute__((ext_vector_type(4)));
__device__ __forceinline__ void kload8(bf16x8*kf,lds_cptr kp){
  kf[0]=*(const __attribute__((address_space(3))) bf16x8*)(kp);      kf[1]=*(const __attribute__((address_space(3))) bf16x8*)(kp+512);
  kf[2]=*(const __attribute__((address_space(3))) bf16x8*)(kp+2048); kf[3]=*(const __attribute__((address_space(3))) bf16x8*)(kp+2560);
  kf[4]=*(const __attribute__((address_space(3))) bf16x8*)(kp+4096); kf[5]=*(const __attribute__((address_space(3))) bf16x8*)(kp+4608);
  kf[6]=*(const __attribute__((address_space(3))) bf16x8*)(kp+6144); kf[7]=*(const __attribute__((address_space(3))) bf16x8*)(kp+6656);
}
__device__ __forceinline__ void kload2(bf16x8*kf,lds_cptr kp,int j){ kf[2*j]=*(const __attribute__((address_space(3))) bf16x8*)(kp+j*2048); kf[2*j+1]=*(const __attribute__((address_space(3))) bf16x8*)(kp+j*2048+512); }
__device__ __forceinline__ s16x4 vtr(lds_cptr p){ return __builtin_bit_cast(s16x4,__builtin_amdgcn_ds_read_tr16_b64_v4i16((__attribute__((address_space(3))) v4i16_t*)p)); }
__device__ __forceinline__ float rowmax(const f32x16&p0,const f32x16&p1){
  float a=max3f(p0[0],p0[1],p1[0]),b=max3f(p0[2],p0[3],p1[1]);a=max3f(a,p1[2],p1[3]);
  #pragma unroll
  for(int r=4;r<16;r+=4){a=max3f(a,p0[r],p0[r+1]);b=max3f(b,p0[r+2],p0[r+3]);a=max3f(a,p1[r],p1[r+1]);b=max3f(b,p1[r+2],p1[r+3]);}
  const float m=max2f(a,b);
  auto rr=__builtin_amdgcn_permlane32_swap(__float_as_uint(m),__float_as_uint(m),false,false);
  return max2f(__uint_as_float(rr[0]),__uint_as_float(rr[1]));
}
__device__ __forceinline__ void pv(f32x16*o,int vb,bf16x8 pa0,bf16x8 pa1,bf16x8 pa2,bf16x8 pa3){
  #pragma unroll
  for(int d0=0;d0<2;++d0){s16x4 lo[4],hi[4];
    #pragma unroll
    for(int ks=0;ks<4;++ks){
      asm volatile("ds_read_b64_tr_b16 %0,%1 offset:%c2":"=&v"(lo[ks]):"v"(vb),"i"(d0*4096+ks*1024):"memory");
      asm volatile("ds_read_b64_tr_b16 %0,%1 offset:%c2":"=&v"(hi[ks]):"v"(vb),"i"(d0*4096+ks*1024+512):"memory");}
    asm volatile("s_waitcnt lgkmcnt(0)":::"memory");SBAR();
    #define PK(k) (bf16x8){lo[k][0],lo[k][1],lo[k][2],lo[k][3],hi[k][0],hi[k][1],hi[k][2],hi[k][3]}
    o[d0]=__builtin_amdgcn_mfma_f32_32x32x16_bf16(pa0,PK(0),o[d0],0,0,0);
    o[d0]=__builtin_amdgcn_mfma_f32_32x32x16_bf16(pa1,PK(1),o[d0],0,0,0);
    o[d0]=__builtin_amdgcn_mfma_f32_32x32x16_bf16(pa2,PK(2),o[d0],0,0,0);
    o[d0]=__builtin_amdgcn_mfma_f32_32x32x16_bf16(pa3,PK(3),o[d0],0,0,0);
    #undef PK
  }
}

#ifndef ATTN_STORE16
#define ATTN_STORE16(p,v) (*(u32x4*)(p)=(v))
#endif
template<int THRL> __device__ __forceinline__ void attn_unit(const bf16*Qrow0,const bf16*__restrict__ Kh,const bf16*__restrict__ Vh,bf16*Orow0,const int NT,const int woff,const int kq0,const float sinkl,const bool has_sink,const bool domask,char*shm,const int tid){
  const int lane=tid&63,r32=lane&31,hi=lane>>5; const int wid=__builtin_amdgcn_readfirstlane(tid>>6);
  const bf16*Qw=Qrow0+(long)(wid*QBLK)*QP;
  const unsigned lds0=(unsigned)(uintptr_t)shm;
  float*wsf=(float*)(shm+LDS_WS)+wid*64;
  const bf16*ksrc=Kh+(long)lane*QP+wid*8;
  const bf16*vsrc=Vh+(long)(16*(wid&3)+(lane>>2))*QP+(wid>>2)*32+(lane&3)*8;
  const unsigned kdst=lds0+LDS_K+wid*1024, vdst=lds0+LDS_V+wid*1024;
  #define KROW(t) (KVBLK*(t)+(((t)>=4)?woff:0))
  #define DMA_K(t,slot) glds16(ksrc+(long)KROW(t)*QP,(unsigned)__builtin_amdgcn_readfirstlane(kdst+(slot)))
  #define DMA_V(t,slot) glds16(vsrc+(long)KROW(t)*QP,(unsigned)__builtin_amdgcn_readfirstlane(vdst+(slot)))
  const int vb0=(int)(lds0+LDS_V)+((lane>>4)&1)*32+(lane&3)*8+(4*hi+((lane&15)>>2))*64;
  const char*Kbase=shm+LDS_K; bf16x8 kf[8];
  const lds_cptr shm3=(lds_cptr)shm; const lds_cptr kp0=shm3+LDS_K+hi*1024+r32*16; const lds_cptr vp0=shm3+LDS_V+((lane>>4)&1)*32+(lane&3)*8+(4*hi+((lane&15)>>2))*64;
  DMA_K(0,0);DMA_V(0,0);DMA_K(1,SLOTB);
  bf16x8 qr[4];
  #pragma unroll
  for(int d0=0;d0<4;++d0)qr[d0]=*reinterpret_cast<const bf16x8*>(&Qw[(long)r32*QP+d0*16+hi*8]);
  float mhat=0.f,l_reg=0.f;f32x16 o[2];o[0]=f32x16{};o[1]=f32x16{};f32x16 negm=f32x16{};asm volatile("":"+v"(negm));
  const int qrel=wid*QBLK+r32;
  #define CMASK(P0,P1,t) do{ if(domask&&(t)>=4) wmask(P0,P1,kq0+KVBLK*(t)-qrel,hi); }while(0)
  bool resc=false;
  #define START(P0,P1) do{ const float rm=rowmax(P0,P1); resc=false; \
    { const float dl=rm; mhat=fadd_s(mhat,dl); \
      _Pragma("unroll") for(int r=0;r<16;++r){P0[r]=fsub_s(P0[r],dl);P1[r]=fsub_s(P1[r],dl);} \
      _Pragma("unroll") for(int r=0;r<16;++r)negm[r]=-mhat; asm volatile("":"+v"(negm)); } \
    _Pragma("unroll") for(int r=0;r<16;++r)P0[r]=__builtin_amdgcn_exp2f(P0[r]); }while(0)
  #define RESC() do{ if(resc){ asm volatile("s_waitcnt lgkmcnt(0)":::"memory"); \
      _Pragma("unroll") for(int d_=0;d_<2;++d_) _Pragma("unroll") for(int r=0;r<16;++r)o[d_][r]*=wsf[crow(r,hi)]; } }while(0)
  f32x16 pA0,pA1,pB0,pB1;
  int sl_prev=0,sl_cur=0,sl_next=SLOTB;
  #define ROT() do{sl_prev=sl_cur;sl_cur=sl_next;sl_next=(sl_next==(NSLOT-1)*SLOTB)?0:sl_next+SLOTB;}while(0)
  DMA_K(2,2*SLOTB);
  WAIT_BAR(3);
  qkt(pA0,pA1,Kbase,qr,negm,r32,hi);asm volatile("s_nop 15\n\ts_nop 7":"+v"(pA0),"+v"(pA1));CMASK(pA0,pA1,0);
  START(pA0,pA1);
  _Pragma("unroll") for(int r=0;r<16;++r)pA1[r]=__builtin_amdgcn_exp2f(pA1[r]);
  WAIT_BAR(0);
  DMA_K(3,0);DMA_V(1,SLOTB);
  ROT();
  kload8(kf,kp0+sl_cur);
  WAIT_BAR(2);
  s16x4 vlo[8],vhi[8]; u32x4 pw0,pw1,pw2,pw3;
  #define PKW(P,B) cvtpk_s(P[B],P[B+1])
  #define PAF(k) __builtin_bit_cast(bf16x8,pw##k)
  #define VFR(i) (bf16x8){vlo[i][0],vlo[i][1],vlo[i][2],vlo[i][3],vhi[i][0],vhi[i][1],vhi[i][2],vhi[i][3]}
  #define PIN(x) asm volatile("":"+v"(x))
  #define MX3(a,b,c) __builtin_fmaxf(__builtin_fmaxf((a),(b)),(c))
  #define GAPA(MF,A0,A1,A2,A3,W0,W1,PW) do{ MF; sacc+=A0; sacc+=A1; sacc+=A2; sacc+=A3; PIN(sacc); W0; W1; PIN(PW); SBAR(); }while(0)
  #define EX(v) __builtin_amdgcn_exp2f(v)
  #define GAPB(MF,X,B) do{ MF; X[B]=EX(X[B]); X[B+1]=EX(X[B+1]); X[B+2]=EX(X[B+2]); X[B+3]=EX(X[B+3]); PIN(X); SBAR(); }while(0)
  #define VRD(i) do{ vlo[i]=vtr(vp_+(((i)>>2)*4096+((i)&3)*1024)); vhi[i]=vtr(vp_+(((i)>>2)*4096+((i)&3)*1024+512)); }while(0)
  #define KRD(G,j) do{ if(G){ kload2(kf,kp0+sl_next,j); SBAR(); } }while(0)
  #define STEP(C0,C1,P0,P1,t,GK,GV,GL) do{ SBAR(); \
    const lds_cptr vp_=vp0+sl_prev; \
    VRD(0); SBAR(); float sacc=(P0[0]+P0[1]); \
    GAPA(C0=__builtin_amdgcn_mfma_f32_32x32x16_bf16(kf[0],qr[0],negm,0,0,0), P0[2],P0[3],P0[4],P0[5],     pw0[0]=PKW(P0,0), pw0[1]=PKW(P0,2), pw0); \
    VRD(4); SBAR(); GAPA(C1=__builtin_amdgcn_mfma_f32_32x32x16_bf16(kf[1],qr[0],negm,0,0,0), P0[6],P0[7],P0[8],P0[9],     pw0[2]=PKW(P0,4), pw0[3]=PKW(P0,6), pw0); \
    VRD(1); SBAR(); GAPA(C0=__builtin_amdgcn_mfma_f32_32x32x16_bf16(kf[2],qr[1],C0,0,0,0),   P0[10],P0[11],P0[12],P0[13], pw1[0]=PKW(P0,8), pw1[1]=PKW(P0,10), pw1); \
    VRD(5); SBAR(); GAPA(C1=__builtin_amdgcn_mfma_f32_32x32x16_bf16(kf[3],qr[1],C1,0,0,0),   P0[14],P0[15],P1[0],P1[1],   pw1[2]=PKW(P0,12),pw1[3]=PKW(P0,14), pw1); \
    VRD(2); SBAR(); GAPA(C0=__builtin_amdgcn_mfma_f32_32x32x16_bf16(kf[4],qr[2],C0,0,0,0),   P1[2],P1[3],P1[4],P1[5],     pw2[0]=PKW(P1,0), pw2[1]=PKW(P1,2), pw2); \
    VRD(6); SBAR(); GAPA(C1=__builtin_amdgcn_mfma_f32_32x32x16_bf16(kf[5],qr[2],C1,0,0,0),   P1[6],P1[7],P1[8],P1[9],     pw2[2]=PKW(P1,4), pw2[3]=PKW(P1,6), pw2); \
    VRD(3); SBAR(); GAPA(C0=__builtin_amdgcn_mfma_f32_32x32x16_bf16(kf[6],qr[3],C0,0,0,0),   P1[10],P1[11],P1[12],P1[13], pw3[0]=PKW(P1,8), pw3[1]=PKW(P1,10), pw3); \
    VRD(7); SBAR(); GAPA(C1=__builtin_amdgcn_mfma_f32_32x32x16_bf16(kf[7],qr[3],C1,0,0,0),   P1[14],P1[15],0.f,0.f,       pw3[2]=PKW(P1,12),pw3[3]=PKW(P1,14), pw3); \
    l_reg+=sacc; \
    if(GK){DMA_K((t)+3,sl_cur);} if(GV){DMA_V((t)+1,sl_next);} \
    CMASK(C0,C1,t); \
    { float a=MX3(C0[0],C0[1],C1[0]),b=MX3(C0[2],C0[3],C1[1]); a=MX3(a,C1[2],C1[3]); \
      _Pragma("unroll") for(int r=4;r<16;r+=4){a=MX3(a,C0[r],C0[r+1]);b=MX3(b,C0[r+2],C0[r+3]);a=MX3(a,C1[r],C1[r+1]);b=MX3(b,C1[r+2],C1[r+3]);} \
      float rm=__builtin_fmaxf(a,b); { auto rr=__builtin_amdgcn_permlane32_swap(__float_as_uint(rm),__float_as_uint(rm),false,false); rm=__builtin_fmaxf(__uint_as_float(rr[0]),__uint_as_float(rr[1])); } \
      resc=false; \
      if(__builtin_expect(__any(rm>(float)THRL),0)){ const float dl=__builtin_fmaxf(rm,0.f); mhat+=dl; \
        _Pragma("unroll") for(int r=0;r<16;++r){C0[r]-=dl;C1[r]-=dl;} \
        _Pragma("unroll") for(int r=0;r<16;++r)negm[r]=-mhat; asm volatile("":"+v"(negm)); \
        const float f=__builtin_amdgcn_exp2f(-dl); l_reg*=f; if(hi==0)wsf[r32]=f; resc=true; } } \
    SBAR(); \
    GAPB(o[0]=__builtin_amdgcn_mfma_f32_32x32x16_bf16(PAF(0),VFR(0),o[0],0,0,0), C0,0); \
    GAPB(o[1]=__builtin_amdgcn_mfma_f32_32x32x16_bf16(PAF(0),VFR(4),o[1],0,0,0), C0,4); \
    KRD(GL,0); GAPB(o[0]=__builtin_amdgcn_mfma_f32_32x32x16_bf16(PAF(1),VFR(1),o[0],0,0,0), C0,8); \
    KRD(GL,1); GAPB(o[1]=__builtin_amdgcn_mfma_f32_32x32x16_bf16(PAF(1),VFR(5),o[1],0,0,0), C0,12); \
    KRD(GL,2); GAPB(o[0]=__builtin_amdgcn_mfma_f32_32x32x16_bf16(PAF(2),VFR(2),o[0],0,0,0), C1,0); \
    KRD(GL,3); GAPB(o[1]=__builtin_amdgcn_mfma_f32_32x32x16_bf16(PAF(2),VFR(6),o[1],0,0,0), C1,4); \
    GAPB(o[0]=__builtin_amdgcn_mfma_f32_32x32x16_bf16(PAF(3),VFR(3),o[0],0,0,0), C1,8); \
    GAPB(o[1]=__builtin_amdgcn_mfma_f32_32x32x16_bf16(PAF(3),VFR(7),o[1],0,0,0), C1,12); \
    }while(0)
  int t=1;
  for(;t+5<NT;t+=2){
    STEP(pB0,pB1,pA0,pA1,t,true,true,true);     WAIT_BAR(2); RESC(); ROT();
    STEP(pA0,pA1,pB0,pB1,t+1,true,true,true);   WAIT_BAR(2); RESC(); ROT();
  }
  #define ENDW(tt) do{ if((tt)+3<NT){WAIT_BAR(2);} else if((tt)+2<NT){WAIT_BAR(1);} else {WAIT_BAR(0);} }while(0)
  for(;t+1<NT;t+=2){
    STEP(pB0,pB1,pA0,pA1,t,(t+3<NT),(t+1<NT),(t+1<NT));       ENDW(t);   RESC(); ROT();
    STEP(pA0,pA1,pB0,pB1,t+1,(t+4<NT),(t+2<NT),(t+2<NT));     ENDW(t+1); RESC(); ROT();
  }
  STEP(pB0,pB1,pA0,pA1,NT-1,false,false,false); RESC();
  { float sacc=pB0[0]+pB0[1]; _Pragma("unroll") for(int r=2;r<16;++r)sacc+=pB0[r]; _Pragma("unroll") for(int r=0;r<16;++r)sacc+=pB1[r]; l_reg+=sacc;
    pw0=(u32x4){PKW(pB0,0),PKW(pB0,2),PKW(pB0,4),PKW(pB0,6)};pw1=(u32x4){PKW(pB0,8),PKW(pB0,10),PKW(pB0,12),PKW(pB0,14)};pw2=(u32x4){PKW(pB1,0),PKW(pB1,2),PKW(pB1,4),PKW(pB1,6)};pw3=(u32x4){PKW(pB1,8),PKW(pB1,10),PKW(pB1,12),PKW(pB1,14)};
    SBAR(); pv(o,vb0+sl_cur,PAF(0),PAF(1),PAF(2),PAF(3)); }
  #undef PKW
  #undef PAF
  #undef VFR
  #undef PIN
  #undef MX3
  #undef GAPA
  #undef GAPB
  #undef EX
  #undef VRD
  #undef KRD
  #undef STEP
  #undef ENDW
  {auto rr=__builtin_amdgcn_permlane32_swap(__float_as_uint(l_reg),__float_as_uint(l_reg),false,false);l_reg=__uint_as_float(rr[0])+__uint_as_float(rr[1]);}
  if(has_sink)l_reg+=__builtin_amdgcn_exp2f(sinkl-mhat);
  if(hi==0)wsf[32+r32]=l_reg;asm volatile("s_waitcnt lgkmcnt(0)":::"memory");
  float rli[16];
  #pragma unroll
  for(int r=0;r<16;++r)rli[r]=__builtin_amdgcn_rcpf(wsf[32+crow(r,hi)]);
  bf16*Ow=Orow0+(long)(wid*QBLK)*OP;
  { bf16*stg=(bf16*)(shm+LDS_OST)+wid*2048;
    #pragma unroll
    for(int r=0;r<16;++r){const int orow=crow(r,hi);
      #pragma unroll
      for(int d0=0;d0<2;++d0)stg[orow*64+d0*32+r32]=(bf16)(cvtpk_s(o[d0][r]*rli[r],0.f)&0xffffu);}
    asm volatile("s_waitcnt lgkmcnt(0)":::"memory");
    #pragma unroll
    for(int i=0;i<4;++i){const int row=i*8+(lane>>3),ch=lane&7; const u32x4 v=*(const u32x4*)(stg+row*64+ch*8); ATTN_STORE16(Ow+(long)row*OP+ch*8,v);} }
  asm volatile("s_waitcnt lgkmcnt(0)\n\ts_barrier":::"memory");
  #undef DMA_K
  #undef KROW
  #undef DMA_V
  #undef CMASK
  #undef START
  #undef RESC
  #undef ROT
}
constexpr int ATTN_LDS_BYTES=LDS_BYTES;
#undef SBAR
#undef WAIT_BAR
}

__device__ __forceinline__ void attn_fast_phase(Ctx& c, int l) {
    const int vcu = (c.G % 8 == 0) ? (c.bx % 8) * (c.G / 8) + c.bx / 8 : c.bx;
    const bf16* P = c_P; bf16* MIX = c_ACT; char* shm = (char*)c.lds;
    const int nit = (l == 0) ? 3 : 2;
    for (int g = vcu; g < 256; g += c.G)
        for (int it = 0; it < nit; ++it) {
            int b, hq, pc, ocol, NTl, woff = 0, kq0 = 0; size_t qrow; bool sink = false, domask = false;
            if (it < 2) { b = g >> 5; hq = (g >> 3) & 3; const int qb = g & 7; qrow = (size_t)b * TPB + CTXL + qb * 256; pc = it ? PC_C : PC_B; ocol = 512 + it * 256 + hq * 64;
                if (it == 0) NTl = 36;
                else { const int w0 = 4 * qb - 2 > 0 ? 4 * qb - 2 : 0, we = 4 * qb + 5 < 31 ? 4 * qb + 5 : 31; NTl = 4 + we - w0 + 1; woff = w0 * 64; kq0 = (w0 - 4) * 64 - qb * 256; sink = true; domask = true; } }
            else { if (g >= 64) continue; const int typ = g >> 5; b = (g >> 2) & 7; hq = g & 3; qrow = (size_t)b * TPB; pc = typ ? PC_C : PC_B; ocol = 512 + typ * 256 + hq * 64; NTl = 4; sink = typ == 1; }
            const float sinkl = sink ? c_in(16)[l * 4 + hq] * LOG2E : 0.f;
            const bf16* Kh = P + (size_t)b * TPB * NP + pc + 256 + (hq >> 1) * 64;
            attn_body::attn_unit<8>(P + qrow * NP + pc + hq * 64, Kh, Kh + 128, MIX + qrow * DM + ocol, NTl, woff, kq0, sinkl, sink, domask, shm, c.tid);
        }
}
namespace gdn {
typedef short s16x4 __attribute__((ext_vector_type(4)));
typedef float f32x2_t __attribute__((ext_vector_type(2))); typedef __bf16 bf16x2_t __attribute__((ext_vector_type(2)));
__device__ __forceinline__ unsigned cvtpk(float lo, float hi) { f32x2_t v = {lo, hi}; bf16x2_t b = __builtin_convertvector(v, bf16x2_t); return __builtin_bit_cast(unsigned, b); }
__device__ __forceinline__ s16x4 pack4(const f32x4& v) { unsigned a = cvtpk(v[0], v[1]), b = cvtpk(v[2], v[3]); typedef unsigned u32x2 __attribute__((ext_vector_type(2))); u32x2 u = {a, b}; return __builtin_bit_cast(s16x4, u); }
__device__ __forceinline__ bf16x8 cat44(s16x4 a, s16x4 b) { return (bf16x8){a[0], a[1], a[2], a[3], b[0], b[1], b[2], b[3]}; }
#define GD_MFMA(a, b, c) __builtin_amdgcn_mfma_f32_16x16x32_bf16((a), (b), (c), 0, 0, 0)
#define GD_BAR() asm volatile("s_waitcnt lgkmcnt(0)\n\ts_barrier" ::: "memory")
constexpr int RP = 72, VP = 68;
constexpr int LQS = 0, LKS = 9216, LVS = 18432, LLM = 35840, LAM = 45056, LQD = 54272, LKET = 63488, LWL = 72704, LSTT = 81920, LDG = 91136, LDI = 95232, DIP = 24,
              LGC = 98304, LBETA = 98560, LEGC = 98816, LEKL = 99072, LSC = 99328, LDS_END = 99392;
#define GD_BF(off) ((LAS bf16*)(lds + (off)))
#define GD_F(off)  ((LAS float*)(lds + (off)))

__device__ __forceinline__ void gdn_fast_unit(const Ctx& c, int l, int u) {
    LAS unsigned char* lds = c.lds;
    const int d = u & 1, h = (u >> 1) & 7, b = u >> 4, lane = c.lane, w = c.wave, g4 = lane >> 4, l15 = lane & 15;
    const bf16* P = c_P; const float* Gt = c_Gt; float* og = c_OG + (size_t)d * NT * 512;
    const float* cw = c_in(8) + (size_t)l * 5 * 1536;
    float wq[5], wk[5], wv[5];
#pragma unroll
    for (int j = 0; j < 5; ++j) { wq[j] = cw[j * 1536 + h * 64 + lane]; wk[j] = cw[j * 1536 + 512 + h * 64 + lane]; wv[j] = cw[j * 1536 + 1024 + h * 64 + lane]; }
    const float Aexp = __expf(c_in(9)[l * 16 + d * 8 + h]), dtb = c_in(10)[l * 16 + d * 8 + h];
    f32x4 Sacc[4];
#pragma unroll
    for (int rt = 0; rt < 4; ++rt) Sacc[rt] = (f32x4){0.f, 0.f, 0.f, 0.f};
    for (int i = c.tid; i < 64 * RP / 2; i += NTHREADS) ((LAS unsigned*)(lds + LSTT))[i] = 0u;
    GD_BAR();
    for (int seg = 0; seg < 2; ++seg) {
        const int len = seg ? SEQ : CTXL, base = b * TPB + (seg ? CTXL : 0), nch = len / 64;
        const bool store_o = !(seg == 0 && l == NL - 1);
        for (int ci = 0; ci < nch; ++ci) {
            const int c0 = d ? len - 64 - 64 * ci : 64 * ci;
            {
                const int tb = d ? c0 + 56 - 8 * w : c0 + 8 * w;
                float xq[12], xk[12], xv[12];
#pragma unroll
                for (int m = 0; m < 12; ++m) { const int tok = tb - 2 + m; const bool valid = tok >= 0 && tok < len; const bf16* pr = P + (size_t)(base + (valid ? tok : 0)) * NP + h * 64 + lane;
                    xq[m] = valid ? bf2f(pr[0]) : 0.f; xk[m] = valid ? bf2f(pr[512]) : 0.f; xv[m] = valid ? bf2f(pr[1024]) : 0.f; }
                float yq[8], yk[8], yv[8], sq[8], sk[8];
#pragma unroll
                for (int i = 0; i < 8; ++i) { float aq = 0.f, ak = 0.f, av = 0.f;
#pragma unroll
                    for (int j = 0; j < 5; ++j) { aq += wq[j] * xq[i + j]; ak += wk[j] * xk[i + j]; av += wv[j] * xv[i + j]; }
                    yq[i] = siluf(aq); yk[i] = siluf(ak); yv[i] = siluf(av); sq[i] = yq[i] * yq[i]; sk[i] = yk[i] * yk[i]; }
#pragma unroll
                for (int o = 1; o < 64; o <<= 1) {
#pragma unroll
                    for (int i = 0; i < 8; ++i) { sq[i] += lane_xor(sq[i], o, lane); sk[i] += lane_xor(sk[i], o, lane); } }
#pragma unroll
                for (int i = 0; i < 8; ++i) { const int r = d ? 8 * w + 7 - i : 8 * w + i;
                    GD_BF(LQS)[r * RP + lane] = (bf16)f2bf(yq[i] * rsqrtf(sq[i] + 1e-6f) * 0.125f);
                    GD_BF(LKS)[r * RP + lane] = (bf16)f2bf(yk[i] * rsqrtf(sk[i] + 1e-6f));
                    GD_F(LVS)[r * VP + lane] = yv[i]; }
            }
            if (w == 0) {
                const int R = base + (d ? c0 + 63 - lane : c0 + lane);
                const float braw = Gt[(size_t)R * 32 + d * 8 + h], araw = Gt[(size_t)R * 32 + 16 + d * 8 + h] + dtb;
                const float beta = 1.f / (1.f + __expf(-braw));
                const float sp = araw > 20.f ? araw : log1pf(__expf(araw));
                float gc = -Aexp * sp;
#pragma unroll
                for (int o = 1; o < 64; o <<= 1) { const float t = __builtin_bit_cast(float, __builtin_amdgcn_ds_bpermute(((lane - o) & 63) << 2, __builtin_bit_cast(int, gc))); if (lane >= o) gc += t; }
                const float gl = __builtin_bit_cast(float, __builtin_amdgcn_readlane(__builtin_bit_cast(int, gc), 63));
                GD_F(LGC)[lane] = gc; GD_F(LBETA)[lane] = beta; GD_F(LEGC)[lane] = __expf(gc); GD_F(LEKL)[lane] = __expf(gl - gc);
                if (lane == 0) GD_F(LSC)[0] = __expf(gl);
            }
            GD_BAR();
            {
                const int mat = w >> 2, ti = w & 3;
                LAS const bf16* As = mat ? GD_BF(LQS) : GD_BF(LKS);
                const bf16x8 a0 = *(LAS const bf16x8*)(As + (16 * ti + l15) * RP + 8 * g4), a1 = *(LAS const bf16x8*)(As + (16 * ti + l15) * RP + 32 + 8 * g4);
                float gci[4], bti[4];
#pragma unroll
                for (int r = 0; r < 4; ++r) { gci[r] = GD_F(LGC)[16 * ti + 4 * g4 + r]; bti[r] = GD_F(LBETA)[16 * ti + 4 * g4 + r]; }
#pragma unroll
                for (int tj = 0; tj < 4; ++tj) {
                    f32x4 acc = (f32x4){0.f, 0.f, 0.f, 0.f};
                    if (tj <= ti) {
                        const bf16x8 b0 = *(LAS const bf16x8*)(GD_BF(LKS) + (16 * tj + l15) * RP + 8 * g4), b1 = *(LAS const bf16x8*)(GD_BF(LKS) + (16 * tj + l15) * RP + 32 + 8 * g4);
                        acc = GD_MFMA(a0, b0, acc); acc = GD_MFMA(a1, b1, acc);
                    }
                    const int j = 16 * tj + l15; const float gcj = GD_F(LGC)[j];
#pragma unroll
                    for (int r = 0; r < 4; ++r) { const int i = 16 * ti + 4 * g4 + r;
                        const float dec = __expf(fminf(gci[r] - gcj, 0.f));
                        if (mat == 0) { const float Lij = (i > j) ? bti[r] * acc[r] * dec : 0.f; GD_BF(LLM)[i * RP + j] = (bf16)f2bf(-Lij); if (tj == ti) GD_F(LDG)[(ti * 16 + (i & 15)) * 16 + l15] = Lij; }
                        else { const float Aij = (i >= j) ? acc[r] * dec : 0.f; GD_BF(LAM)[i * RP + j] = (bf16)f2bf(Aij); } }
                }
            }
            GD_BAR();
            if (w == 0) {
                const int bb = lane >> 4, cc = lane & 15; LAS const float* N = GD_F(LDG) + bb * 256;
                float x[16];
#pragma unroll
                for (int i = 0; i < 16; ++i) { float a = (i == cc) ? 1.f : 0.f;
#pragma unroll
                    for (int j = 0; j < i; ++j) a -= N[i * 16 + j] * x[j];
                    x[i] = a; }
#pragma unroll
                for (int i = 0; i < 16; ++i) GD_BF(LDI)[(bb * 16 + i) * DIP + cc] = (bf16)f2bf(x[i]);
            } else if (w >= 4) {
                const int t2 = c.tid - 256, r = t2 >> 2, q0 = (t2 & 3) * 16; const float eg = GD_F(LEGC)[r], ek = GD_F(LEKL)[r];
#pragma unroll
                for (int cc = 0; cc < 16; ++cc) { const int col = q0 + cc;
                    GD_BF(LQD)[r * RP + col] = (bf16)f2bf(bf2f(GD_BF(LQS)[r * RP + col]) * eg);
                    GD_BF(LKET)[col * RP + r] = (bf16)f2bf(bf2f(GD_BF(LKS)[r * RP + col]) * ek); }
            }
            GD_BAR();
            f32x4 X[4];
            {
                s16x4 Xp[4]; const s16x4 z4 = (s16x4){0, 0, 0, 0};
#pragma unroll
                for (int bb = 0; bb < 4; ++bb) {
                    f32x4 Y;
#pragma unroll
                    for (int r = 0; r < 4; ++r) { const int i = 16 * bb + 4 * g4 + r; const float bt = GD_F(LBETA)[i];
                        Y[r] = (w < 4) ? bt * GD_F(LVS)[i * VP + 16 * w + l15] : bt * GD_F(LEGC)[i] * bf2f(GD_BF(LKS)[i * RP + 16 * (w - 4) + l15]); }
                    LAS const bf16* lrow = GD_BF(LLM) + (16 * bb + l15) * RP + 4 * g4;
                    if (bb >= 1) { const s16x4 la = *(LAS const s16x4*)(lrow), lb = (bb >= 2) ? *(LAS const s16x4*)(lrow + 16) : z4;
                        Y = GD_MFMA(cat44(la, lb), cat44(Xp[0], (bb >= 2) ? Xp[1] : z4), Y); }
                    if (bb == 3) { const s16x4 la = *(LAS const s16x4*)(lrow + 32); Y = GD_MFMA(cat44(la, z4), cat44(Xp[2], z4), Y); }
                    const s16x4 di = *(LAS const s16x4*)(GD_BF(LDI) + (bb * 16 + l15) * DIP + 4 * g4);
                    X[bb] = GD_MFMA(cat44(di, z4), cat44(pack4(Y), z4), ((f32x4){0.f, 0.f, 0.f, 0.f}));
                    Xp[bb] = pack4(X[bb]);
                }
                if (w >= 4) {
#pragma unroll
                    for (int bb = 0; bb < 4; ++bb)
#pragma unroll
                        for (int r = 0; r < 4; ++r) GD_BF(LWL)[(16 * bb + 4 * g4 + r) * RP + 16 * (w - 4) + l15] = (bf16)f2bf(-X[bb][r]);
                }
            }
            GD_BAR();
            if (w < 4) {
                const bf16x8 sb0 = *(LAS const bf16x8*)(GD_BF(LSTT) + (16 * w + l15) * RP + 8 * g4), sb1 = *(LAS const bf16x8*)(GD_BF(LSTT) + (16 * w + l15) * RP + 32 + 8 * g4);
                f32x4 Vn[4];
#pragma unroll
                for (int rt = 0; rt < 4; ++rt) { LAS const bf16* wr = GD_BF(LWL) + (16 * rt + l15) * RP + 8 * g4;
                    Vn[rt] = GD_MFMA(*(LAS const bf16x8*)(wr), sb0, X[rt]); Vn[rt] = GD_MFMA(*(LAS const bf16x8*)(wr + 32), sb1, Vn[rt]); }
                const bf16x8 vp0 = cat44(pack4(Vn[0]), pack4(Vn[1])), vp1 = cat44(pack4(Vn[2]), pack4(Vn[3]));
                const float egl = GD_F(LSC)[0];
#pragma unroll
                for (int rt = 0; rt < 4; ++rt) {
                    LAS const bf16* qr = GD_BF(LQD) + (16 * rt + l15) * RP + 8 * g4; LAS const bf16* ar = GD_BF(LAM) + (16 * rt + l15) * RP + 4 * g4;
                    f32x4 O = GD_MFMA(*(LAS const bf16x8*)(qr), sb0, ((f32x4){0.f, 0.f, 0.f, 0.f})); O = GD_MFMA(*(LAS const bf16x8*)(qr + 32), sb1, O);
                    O = GD_MFMA(cat44(*(LAS const s16x4*)(ar), *(LAS const s16x4*)(ar + 16)), vp0, O);
                    O = GD_MFMA(cat44(*(LAS const s16x4*)(ar + 32), *(LAS const s16x4*)(ar + 48)), vp1, O);
                    if (store_o) {
#pragma unroll
                        for (int r = 0; r < 4; ++r) { const int i = 16 * rt + 4 * g4 + r; const int R = base + (d ? c0 + 63 - i : c0 + i); og[(size_t)R * 512 + h * 64 + 16 * w + l15] = O[r]; } }
                }
#pragma unroll
                for (int rt = 0; rt < 4; ++rt) { LAS const bf16* kr = GD_BF(LKET) + (16 * rt + l15) * RP + 4 * g4;
                    f32x4 S2 = Sacc[rt] * egl;
                    S2 = GD_MFMA(cat44(*(LAS const s16x4*)(kr), *(LAS const s16x4*)(kr + 16)), vp0, S2);
                    S2 = GD_MFMA(cat44(*(LAS const s16x4*)(kr + 32), *(LAS const s16x4*)(kr + 48)), vp1, S2);
                    Sacc[rt] = S2; }
#pragma unroll
                for (int rt = 0; rt < 4; ++rt) *(LAS s16x4*)(GD_BF(LSTT) + (16 * w + l15) * RP + 16 * rt + 4 * g4) = pack4(Sacc[rt]);
            }
            GD_BAR();
        }
    }
}
#undef GD_BF
#undef GD_F
}

__device__ __forceinline__ void gdn_combine_phase(Ctx& c, int l) {
    const float* gn = c_in(11) + l * 64;
    for (int u = c.gw; u < NT * GH; u += c.NGW) {
        const int R = u >> 3, h = u & 7; const int tp = R % TPB;
        if (l == NL - 1 && tp < CTXL) continue;
        const size_t o0 = (size_t)R * 512 + h * 64 + c.lane;
        const float o = c_OG[o0] + c_OG[(size_t)NT * 512 + o0];
        const float rstd = rsqrtf(wave_sum(o * o) * (1.f / 64.f) + RMS_EPS);
        const float z = bf2f(c_P[(size_t)R * NP + PC_Z + h * 64 + c.lane]);
        c_ACT[(size_t)R * DM + h * 64 + c.lane] = (bf16)f2bf(o * rstd * gn[c.lane] * siluf(z));
    }
}

__global__ void __launch_bounds__(NTHREADS, 2) mk_fwd(Args args) {
    extern __shared__ __attribute__((aligned(16))) unsigned char lds_raw[];
    typedef const __attribute__((address_space(4))) Args* KArgs;
    int wave_sgpr, lo, hi; unsigned char* ws;
    XcdBarrier bar;
    {
        const int tid0 = threadIdx.x; wave_sgpr = __builtin_amdgcn_readfirstlane(tid0 >> 6);
        KArgs A0 = (KArgs)__builtin_amdgcn_kernarg_segment_ptr();
        ws = A0->ws; lo = A0->ph_lo; hi = A0->ph_hi;
        LAS unsigned char* l0 = (LAS unsigned char*)lds_raw;
        for (int u = tid0; u < (LDS_BYTES - 131072) / 4; u += NTHREADS) ((LAS unsigned*)(l0 + 131072))[u] = 0u;
        __syncthreads();
        unsigned* barw = (unsigned*)(ws + WS_CTL) + CW_BAR + A0->li * XCD_BAR_WORDS;
        bar.bar = barw; bar.x = 0; bar.st = nullptr;
        if (hi - lo > 1) bar = xcd_barrier_post(barw, (volatile LAS unsigned*)(l0 + MISC_OFF) + 8, tid0 == 0);
    }
#ifndef ONLY
#define ONLY -1
#endif
#define EN(k) (ONLY < 0 || ONLY == (k))
#define PHASE(k, ...) do { const int k_ = (k); if (lo <= k_ && k_ < hi) { Ctx c; \
        { KArgs ap_ = (KArgs)__builtin_amdgcn_kernarg_segment_ptr(); asm volatile("" : "+s"(ap_)); c.A = ap_; } \
        { int w_ = wave_sgpr; asm volatile("" : "+s"(w_)); int l_; asm volatile("v_mbcnt_lo_u32_b32 %0, -1, 0\n\tv_mbcnt_hi_u32_b32 %0, -1, %0" : "=v"(l_)); \
          c.wave = w_; c.lane = l_; c.tid = w_ * 64 + l_; c.G = gridDim.x; c.bx = blockIdx.x; c.gw = c.bx * NWAVES + w_; c.NGW = c.G * NWAVES; c.lds = (LAS unsigned char*)lds_raw; } \
        { __VA_ARGS__ } if (k_ + 1 < hi) xcd_barrier(bar, c.tid == 0); } } while (0)
    PHASE(0, if (EN(10)) conv_weights(c, 0); __syncthreads(); if (EN(11)) ada_mod_phase(c););
#pragma unroll 1
    for (int l = 0; l < NL; ++l) {
        const int p0 = 1 + 9 * l; const bool last = (l == NL - 1);
        PHASE(p0 + 0, if (EN(0)) { if (l > 0) { conv_weights(c, l); __syncthreads(); } norm_phase(c, l, 0); });
        PHASE(p0 + 1, if (EN(1)) {
                { pg8::Gemm g{c_ACT, c_Win_t, NT, NP, DM}; pg8::RowOrder S; S.init(NP, c.G, c.bx, false); pg8::EpiBf16<0> E{c_P, NP, nullptr, 0, 0, 1.f};
                  pg8::gemm_phase<pg8::EpiBf16<0>, pg8::RowOrder, true, true>(c.lds, g, S, E, c.tid); }
                { EpiGates E{c_Gt}; gemm_naive(c, c_ACT, c_Win_t + (size_t)NP * DM, NT, 32, DM, E, false); } });
        PHASE(p0 + 2, if (EN(2)) attn_prep_phase(c, l););
        PHASE(p0 + 3, if (EN(3)) { if (c.bx < 128) gdn::gdn_fast_unit(c, l, c.bx); attn_fast_phase(c, l); });
        PHASE(p0 + 4, if (EN(4)) gdn_combine_phase(c, l););
        PHASE(p0 + 5, if (EN(5)) { pg8::Gemm g{c_ACT, c_Wout_t, NT, DM, DM}; pg8::RowOrder S; S.init(DM, c.G, c.bx, last); pg8::EpiGateRes E{c_XSC, c_out, c_MOD + (size_t)l * 9 * NMODC + 2 * DM};
                  pg8::gemm_phase<pg8::EpiGateRes, pg8::RowOrder, true, true>(c.lds, g, S, E, c.tid); });
        PHASE(p0 + 6, if (EN(6)) norm_phase(c, l, 1););
        PHASE(p0 + 7, if (EN(7)) { pg8::Gemm g{c_ACT, c_W1_t, NT, DFF, DM}; pg8::RowOrder S; S.init(DFF, c.G, c.bx, last); pg8::EpiBf16<2> E{c_H, DFF, nullptr, 0, 0, 1.f};
                  pg8::gemm_phase<pg8::EpiBf16<2>, pg8::RowOrder, true, true>(c.lds, g, S, E, c.tid); });
        PHASE(p0 + 8, if (EN(8)) { pg8::Gemm g{c_H, c_W2_t, NT, DM, DFF}; pg8::RowOrder S; S.init(DM, c.G, c.bx, last); pg8::EpiGateRes E{c_XSC, c_out, c_MOD + (size_t)l * 9 * NMODC + 5 * DM};
                  pg8::gemm_phase<pg8::EpiGateRes, pg8::RowOrder, true, true>(c.lds, g, S, E, c.tid); });
    }
}

#if !MIXER_IN_MAIN
__global__ void __launch_bounds__(NTHREADS, 2) mixer_k(Args args, int l) {
    extern __shared__ __attribute__((aligned(16))) unsigned char lds_raw2[];
    Ctx c; c.A = (const __attribute__((address_space(4))) Args*)__builtin_amdgcn_kernarg_segment_ptr();
    c.tid = threadIdx.x; c.lane = c.tid & 63; c.wave = __builtin_amdgcn_readfirstlane(c.tid >> 6); c.G = gridDim.x; c.bx = blockIdx.x; c.gw = c.bx * NWAVES + c.wave; c.NGW = c.G * NWAVES; c.lds = (LAS unsigned char*)lds_raw2;
    if (c.wave == 0 && c.bx < 128) gdn_naive_unit(c, l, c.bx, (LAS float*)c.lds);
}
#endif
extern "C" void kernel_launch(void* const* d_in, const int* in_sizes, int n_in, void* d_out, int out_size, void* d_ws, size_t ws_size, hipStream_t stream) {
    static int grid = 0;
    if (grid == 0) {
        if (n_in != 21 || out_size != NB * SEQ * DM || ws_size < WS_END) { fprintf(stderr, "kernel_launch: unexpected problem (n_in %d out %d ws %zu)\n", n_in, out_size, ws_size); grid = -1; return; }
        int dev = 0, cus = 0;
        if (hipGetDevice(&dev) != hipSuccess || hipDeviceGetAttribute(&cus, hipDeviceAttributeMultiprocessorCount, dev) != hipSuccess) { grid = -1; return; }
        if (hipFuncSetAttribute((const void*)mk_fwd, hipFuncAttributeMaxDynamicSharedMemorySize, LDS_BYTES) != hipSuccess) { fprintf(stderr, "kernel_launch: hipFuncSetAttribute failed\n"); grid = -1; return; }
        int per_cu = 0;
        if (hipOccupancyMaxActiveBlocksPerMultiprocessor(&per_cu, (const void*)mk_fwd, NTHREADS, LDS_BYTES) != hipSuccess || per_cu < 1) fprintf(stderr, "kernel_launch: occupancy query says %d\n", per_cu);
        (void)hipGetLastError();
        grid = cus;
    }
    if (grid < 0) return;
    if (hipMemsetAsync((char*)d_ws + WS_CTL, 0, CTL_ZERO_BYTES, stream) != hipSuccess) return;
    Args a{};
    for (int i = 0; i < 21; ++i) a.in[i] = (const float*)d_in[i];
    a.out = (float*)d_out; a.ws = (unsigned char*)d_ws;
#if MK_ONE_LAUNCH && MIXER_IN_MAIN
    a.ph_lo = 0; a.ph_hi = NPHASES; a.li = 0;
    hipLaunchKernelGGL(mk_fwd, dim3(grid), dim3(NTHREADS), LDS_BYTES, stream, a);
#elif MK_ONE_LAUNCH
    (void)hipFuncSetAttribute((const void*)mixer_k, hipFuncAttributeMaxDynamicSharedMemorySize, LDS_BYTES);
    for (int l = 0; l < NL; ++l) {
        a.ph_lo = l == 0 ? 0 : 1 + 9 * l - 6; a.ph_hi = 1 + 9 * l + 3; a.li = l;
        hipLaunchKernelGGL(mk_fwd, dim3(grid), dim3(NTHREADS), LDS_BYTES, stream, a);
        hipLaunchKernelGGL(mixer_k, dim3(grid), dim3(NTHREADS), LDS_BYTES, stream, a, l);
    }
    a.ph_lo = 1 + 9 * (NL - 1) + 3; a.ph_hi = NPHASES; a.li = NL;
    hipLaunchKernelGGL(mk_fwd, dim3(grid), dim3(NTHREADS), LDS_BYTES, stream, a);
#else
    for (int ph = 0; ph < NPHASES; ++ph) { a.ph_lo = ph; a.ph_hi = ph + 1; a.li = ph;
        hipLaunchKernelGGL(mk_fwd, dim3(grid), dim3(NTHREADS), LDS_BYTES, stream, a); }
#endif
}
```

```cpp
#include <hip/hip_runtime.h>
#include <cstdio>
#include <cstdint>

#define GAS __attribute__((address_space(1)))
#define LAS __attribute__((address_space(3)))
typedef unsigned short bf16;
typedef short bf16x8 __attribute__((ext_vector_type(8)));
typedef float f32x4 __attribute__((ext_vector_type(4)));
typedef float f32x16 __attribute__((ext_vector_type(16)));
typedef unsigned v4u __attribute__((ext_vector_type(4)));
typedef GAS unsigned gu32;
#define RLX_AGENT __ATOMIC_RELAXED, __HIP_MEMORY_SCOPE_AGENT
#define LDS_WAIT() asm volatile("s_waitcnt lgkmcnt(0)" ::: "memory")

#ifndef MK_ONE_LAUNCH
#define MK_ONE_LAUNCH 1
#endif
#ifndef DUP
#define DUP -1
#endif
#ifndef MIXER_IN_MAIN
#define MIXER_IN_MAIN 1
#endif
constexpr int NWAVES = 8, NTHREADS = NWAVES * 64;

constexpr int DM = 1024, NB = 8, SEQ = 2048, CTXL = 256, TPB = SEQ + CTXL, NT = NB * TPB;
constexpr int NL = 2, DIN = 3104, NP = 3072, DFF = 4096, NMODC = 6 * DM;
constexpr int GH = 8;
constexpr float RMS_EPS = 1e-6f;
constexpr float C2 = 0.125f * 1.4426950408889634f;
constexpr float LOG2E = 1.4426950408889634f;
constexpr int PC_Z = 1536, PC_B = 2048, PC_C = 2560;
constexpr int NPHASES = 1 + 9 * NL;

constexpr size_t MiB = 1u << 20;
constexpr size_t WS_CTL = 0, CTL_ZERO_BYTES = 1 * MiB;
constexpr size_t WS_MOD = 1 * MiB;
constexpr size_t WS_ROPE = WS_MOD + 512 * 1024;
constexpr size_t WS_WIN = 2 * MiB;
constexpr int NPG = NP + 256;
constexpr size_t WS_WOUT = WS_WIN + (size_t)NPG * DM * 2;
constexpr size_t WS_W1 = WS_WOUT + (size_t)DM * DM * 2;
constexpr size_t WS_W2 = WS_W1 + (size_t)DFF * DM * 2;
constexpr size_t WS_XSC = 27 * MiB;
constexpr size_t WS_ACT = 35 * MiB;
constexpr size_t WS_G = 71 * MiB;
constexpr size_t WS_P = 74 * MiB;
constexpr size_t WS_OG = 182 * MiB;
constexpr size_t WS_H = 74 * MiB;
constexpr size_t WS_SLAB = 218 * MiB;
constexpr size_t WS_END = 254 * MiB;
static_assert(WS_H + (size_t)NT * DFF * 2 <= WS_SLAB && WS_SLAB + (size_t)128 * 65536 * 4 <= WS_END, "slabs");
static_assert(WS_W2 + (size_t)DM * DFF * 2 <= WS_XSC, "weights");
static_assert(WS_H + (size_t)NT * DFF * 2 <= WS_END && WS_OG + (size_t)2 * NT * 512 * 4 <= WS_END, "ws map");
constexpr int CW_BAR = 4096;

constexpr int LDS_BYTES = 147456;
constexpr int MISC_OFF = LDS_BYTES - 512;
static_assert(134912 <= MISC_OFF, "GDN LDS map");

__device__ __forceinline__ unsigned f2bf(float f) { unsigned u = __builtin_bit_cast(unsigned, f); return (u + 0x7fffu + ((u >> 16) & 1u)) >> 16; }
__device__ __forceinline__ unsigned pk2(float lo, float hi) { return f2bf(lo) | (f2bf(hi) << 16); }
__device__ __forceinline__ float bf2f(bf16 v) { return __builtin_bit_cast(float, (unsigned)v << 16); }
__device__ __forceinline__ float bfs2f(short v) { return __builtin_bit_cast(float, ((unsigned)(unsigned short)v) << 16); }
__device__ __forceinline__ float lane_xor(float v, int o, int lane) { return __builtin_bit_cast(float, __builtin_amdgcn_ds_bpermute((lane ^ o) << 2, __builtin_bit_cast(int, v))); }
__device__ __forceinline__ float wave_sum_l(float v, int lane) {
#pragma unroll
    for (int o = 1; o < 64; o <<= 1) v += lane_xor(v, o, lane);
    return v;
}
__device__ __forceinline__ float wave_max_l(float v, int lane) {
#pragma unroll
    for (int o = 1; o < 64; o <<= 1) v = fmaxf(v, lane_xor(v, o, lane));
    return v;
}
#define wave_sum(v) wave_sum_l((v), c.lane)
#define wave_max(v) wave_max_l((v), c.lane)
__device__ __forceinline__ float siluf(float v) { return v / (1.f + __expf(-v)); }

#define XB_TMO      128
#define XB_XCNT(j)  (256  + 64 * (j))
#define XB_XSUB(j)  (1280 + 64 * (j))
#define XB_XGEN(j)  (2304 + 64 * (j))
#define XB_TOP      3328
#define XB_TOPGEN   3392
#define XCD_BAR_WORDS 3456
#define XB_SPIN_CAP (1u << 22)
__device__ __forceinline__ unsigned xb_ld(unsigned* p)              { return __hip_atomic_load(p, __ATOMIC_RELAXED, __HIP_MEMORY_SCOPE_AGENT); }
__device__ __forceinline__ unsigned xb_add(unsigned* p, unsigned v) { return __hip_atomic_fetch_add(p, v, __ATOMIC_RELAXED, __HIP_MEMORY_SCOPE_AGENT); }
__device__ __forceinline__ unsigned xb_xcc_id() { return (unsigned)__builtin_amdgcn_s_getreg((3 << 11) | 20) & 0xFu; }
#define XB_SPIN(cond, bar) do { unsigned _sp = 0; while (cond) { __builtin_amdgcn_s_sleep(1); \
    if ((++_sp & 255u) == 0u) { if (xb_ld(&(bar)[XB_TMO])) break; if (_sp > XB_SPIN_CAP) { atomicAdd(&(bar)[XB_TMO], 1u); break; } } } } while (0)
struct XcdBarrier { unsigned* bar; unsigned x; volatile LAS unsigned* st; };
__device__ __forceinline__ XcdBarrier xcd_barrier_post(unsigned* bar, volatile LAS unsigned* st, bool leader) {
    XcdBarrier b; b.bar = bar; b.x = xb_xcc_id(); b.st = st;
    if (leader) (void)xb_add(&bar[XB_XCNT(b.x)], 1u);
    return b;
}
__device__ __forceinline__ void xcd_barrier_complete(unsigned* bar, unsigned x, unsigned& nloc, unsigned& nx) {
    const unsigned G = gridDim.x * gridDim.y * gridDim.z;
    unsigned sum, cnt, mine, sp = 0u;
    for (;;) {
        sum = 0u; cnt = 0u; mine = 0u;
#pragma unroll 1
        for (unsigned j = 0; j < 16; ++j) { const unsigned c = xb_ld(&bar[XB_XCNT(j)]); sum += c; cnt += (c > 0u) ? 1u : 0u; mine = (j == x) ? c : mine; }
        if (sum == G) break;
        __builtin_amdgcn_s_sleep(1);
        if ((++sp & 255u) == 0u) { if (xb_ld(&bar[XB_TMO])) break; if (sp > XB_SPIN_CAP) { atomicAdd(&bar[XB_TMO], 1u); break; } }
    }
    nloc = mine > 0u ? mine : 1u; nx = cnt > 0u ? cnt : 1u;
}
__device__ __forceinline__ void xcd_barrier(const XcdBarrier& b, bool leader) {
    asm volatile("s_waitcnt vmcnt(0)" ::: "memory");
    __syncthreads();
    if (leader) {
        unsigned* bar = b.bar; asm volatile("" : "+s"(bar));
        __builtin_amdgcn_s_waitcnt(0);
        unsigned nloc = b.st[0], nx = b.st[1];
        if (nloc == 0u) { xcd_barrier_complete(bar, b.x, nloc, nx); b.st[0] = nloc; b.st[1] = nx; }
        const unsigned old = xb_add(&bar[XB_XSUB(b.x)], 1u);
        const unsigned gen = old / nloc;
        if (old + 1u == (gen + 1u) * nloc) {
            __builtin_amdgcn_fence(__ATOMIC_RELEASE, "agent");
            asm volatile("s_waitcnt vmcnt(0)" ::: "memory");
            const unsigned og = xb_add(&bar[XB_TOP], 1u);
            const unsigned tg = og / nx;
            if (og + 1u == (tg + 1u) * nx) xb_add(&bar[XB_TOPGEN], 1u);
            else XB_SPIN(xb_ld(&bar[XB_TOPGEN]) == tg, bar);
            __builtin_amdgcn_fence(__ATOMIC_ACQUIRE, "agent");
            xb_add(&bar[XB_XGEN(b.x)], 1u);
            asm volatile("s_waitcnt vmcnt(0)" ::: "memory");
        } else {
            XB_SPIN(xb_ld(&bar[XB_XGEN(b.x)]) == gen, bar);
            __builtin_amdgcn_fence(__ATOMIC_ACQUIRE, "agent");
            asm volatile("s_waitcnt vmcnt(0)" ::: "memory");
        }
    }
    __syncthreads();
}

struct Args { const float* in[21]; float* out; unsigned char* ws; int ph_lo, ph_hi, li, pad; };
struct Ctx {
    LAS unsigned char* lds;
    int tid, lane, wave, G, bx, gw, NGW;
    const __attribute__((address_space(4))) Args* A;
};
#define c_in(i)  (c.A->in[i])
#define c_out    (c.A->out)
#define c_Win_t  ((bf16*)(c.A->ws + WS_WIN))
#define c_Wout_t ((bf16*)(c.A->ws + WS_WOUT))
#define c_W1_t   ((bf16*)(c.A->ws + WS_W1))
#define c_W2_t   ((bf16*)(c.A->ws + WS_W2))
#define c_ACT    ((bf16*)(c.A->ws + WS_ACT))
#define c_P      ((bf16*)(c.A->ws + WS_P))
#define c_H      ((bf16*)(c.A->ws + WS_H))
#define c_XSC    ((float*)(c.A->ws + WS_XSC))
#define c_Gt     ((float*)(c.A->ws + WS_G))
#define c_OG     ((float*)(c.A->ws + WS_OG))
#define c_MOD    ((float*)(c.A->ws + WS_MOD))
#define c_ROPE   ((float*)(c.A->ws + WS_ROPE))
__device__ __forceinline__ float* xs_row(const Ctx& c, int R) {
    const int b = R / TPB, tp = R - b * TPB;
    return tp < CTXL ? c_XSC + ((size_t)(b * CTXL + tp) << 10) : c_out + ((size_t)(b * SEQ + tp - CTXL) << 10);
}
__device__ __forceinline__ const float* in_row(const Ctx& c, int R) {
    const int b = R / TPB, tp = R - b * TPB;
    return tp < CTXL ? c_in(2) + ((size_t)(b * CTXL + tp) << 10) : c_in(0) + ((size_t)(b * SEQ + tp - CTXL) << 10);
}
__device__ __forceinline__ int mod_row(int R) { const int b = R / TPB, tp = R - b * TPB; return tp < CTXL ? 8 : b; }

__device__ __forceinline__ void transpose_item(const float* W, int K, int N, bf16* WT, int k0, int n0, int n0d, LAS float* scr, int lane) {
#pragma unroll 8
    for (int i = 0; i < 32; ++i) { const int kk = 2 * i + (lane >> 5); scr[kk * 33 + (lane & 31)] = W[(size_t)(k0 + kk) * N + n0 + (lane & 31)]; }
    LDS_WAIT(); asm volatile("" ::: "memory");
    const int cch = lane & 7;
#pragma unroll
    for (int j = 0; j < 4; ++j) { const int n = (lane >> 3) + 8 * j; const LAS float* s = scr + (8 * cch) * 33 + n;
        v4u o; o.x = pk2(s[0 * 33], s[1 * 33]); o.y = pk2(s[2 * 33], s[3 * 33]); o.z = pk2(s[4 * 33], s[5 * 33]); o.w = pk2(s[6 * 33], s[7 * 33]);
        *(GAS v4u*)(WT + (size_t)(n0d + n) * K + k0 + 8 * cch) = o; }
    LDS_WAIT(); asm volatile("" ::: "memory");
}
__device__ __forceinline__ void conv_weights(Ctx& c, int l) {
    LAS float* scr = (LAS float*)(c.lds + c.wave * 16384);
    constexpr int I_IN = 16 * 97, I_O = 16 * 32, I_1 = 16 * 128, I_2 = 64 * 32, NITEMS = I_IN + I_O + I_1 + I_2;
    const float* w_in = c_in(7) + (size_t)l * DM * DIN; const float* w_out = c_in(17) + (size_t)l * DM * DM;
    const float* w1 = c_in(19) + (size_t)l * DM * DFF; const float* w2 = c_in(20) + (size_t)l * DFF * DM;
    { unsigned zu_ = 0u; asm volatile("" : "+v"(zu_));
      for (int i = c.gw * 64 + c.lane; i < (NPG - DIN) * DM / 8; i += c.NGW * 64) ((v4u*)(c_Win_t + (size_t)DIN * DM))[i] = (v4u){zu_, zu_, zu_, zu_}; }
    for (int it = c.gw; it < NITEMS; it += c.NGW) {
        int r = it;
        if (r < I_IN) { const int kb = r / 97, nb = r % 97; const int nbd = nb < 64 ? nb : (nb == 64 ? 96 : nb - 1);
            transpose_item(w_in, DM, DIN, c_Win_t, 64 * kb, 32 * nb, 32 * nbd, scr, c.lane); continue; } r -= I_IN;
        if (r < I_O) { const int kb = r / 32, nb = r % 32; transpose_item(w_out, DM, DM, c_Wout_t, 64 * kb, 32 * nb, 32 * nb, scr, c.lane); continue; } r -= I_O;
        if (r < I_1) { const int kb = r / 128, nb = r % 128; transpose_item(w1, DM, DFF, c_W1_t, 64 * kb, 32 * nb, 32 * nb, scr, c.lane); continue; } r -= I_1;
        { const int kb = r / 32, nb = r % 32; transpose_item(w2, DFF, DM, c_W2_t, 64 * kb, 32 * nb, 32 * nb, scr, c.lane); }
    }
}
__device__ __forceinline__ void ada_mod_phase(Ctx& c) {
    LAS float* scond = (LAS float*)c.lds; LAS float* red = scond + 9 * 1024;
    if (c.bx < 192) {
        for (int i = c.tid; i < 9 * 1024; i += NTHREADS) { const int r = i >> 10, k = i & 1023; const float v = r < 8 ? c_in(1)[r * 1024 + k] : c_in(3)[k]; scond[i] = siluf(v); }
        __syncthreads();
        for (int u = c.bx; u < 192; u += c.G) {
            const int l = u / 96, cg = u % 96, col = cg * 64 + c.lane;
            const float* w = c_in(4) + (size_t)l * DM * NMODC + col;
            float acc[9];
#pragma unroll
            for (int r = 0; r < 9; ++r) acc[r] = 0.f;
            const int k0 = c.wave * 128;
#pragma unroll 4
            for (int k = k0; k < k0 + 128; ++k) { const float wv = w[(size_t)k * NMODC];
#pragma unroll
                for (int r = 0; r < 9; ++r) acc[r] += scond[r * 1024 + k] * wv; }
#pragma unroll
            for (int r = 0; r < 9; ++r) red[(c.wave * 9 + r) * 64 + c.lane] = acc[r];
            __syncthreads();
            for (int i = c.tid; i < 576; i += NTHREADS) { const int r = i >> 6, ln = i & 63; float s = 0.f;
#pragma unroll
                for (int w8 = 0; w8 < 8; ++w8) s += red[(w8 * 9 + r) * 64 + ln];
                const int cc = cg * 64 + ln; c_MOD[(size_t)(l * 9 + r) * NMODC + cc] = s + c_in(5)[l * NMODC + cc]; }
            __syncthreads();
        }
    }
    const int gid = c.bx * NTHREADS + c.tid;
    if (gid < 96 * 16) { const int pos = gid >> 4, i = gid & 15; const float inv = powf(10000.f, -(float)i / 16.f);
        const float p = (float)(pos < 32 ? pos : pos - 32); const float a = p * inv; c_ROPE[2 * gid] = cosf(a); c_ROPE[2 * gid + 1] = sinf(a); }
}

__device__ __forceinline__ void norm_phase(Ctx& c, int l, int which  ) {
    const float* g = (which == 0 ? c_in(6) : c_in(18)) + l * DM;
    const bool skip_ctx = (which == 1 && l == NL - 1);
    for (int R = c.gw; R < NT; R += c.NGW) {
        const int b = R / TPB, tp = R - b * TPB;
        if (skip_ctx && tp < CTXL) continue;
        const bool first = (l == 0 && which == 0);
        const float* src = first ? in_row(c, R) : xs_row(c, R);
        const f32x4* xr = (const f32x4*)src + c.lane;
        f32x4 v[4]; float ss = 0.f;
#pragma unroll
        for (int j = 0; j < 4; ++j) v[j] = xr[64 * j];
        if (which == 0 && l > 0 && tp < CTXL) {
            const float* gm = c_MOD + (size_t)((l - 1) * 9 + 8) * NMODC + 5 * DM; const float* slab = (const float*)(c.A->ws + WS_SLAB);
#pragma unroll
            for (int j = 0; j < 4; ++j) { const float* sp = slab + ((size_t)((b * 4 + j) * 4) << 16) + tp * 256 + 4 * c.lane; f32x4 a = *(const f32x4*)sp;
#pragma unroll
                for (int ks = 1; ks < 4; ++ks) a += *(const f32x4*)(sp + ((size_t)ks << 16));
                v[j] = v[j] + *(const f32x4*)(gm + 4 * c.lane + 256 * j) * a; ((f32x4*)xs_row(c, R) + c.lane)[64 * j] = v[j]; } }
#pragma unroll
        for (int j = 0; j < 4; ++j) ss += (v[j].x * v[j].x + v[j].y * v[j].y) + (v[j].z * v[j].z + v[j].w * v[j].w);
        if (first) { f32x4* xo = (f32x4*)xs_row(c, R) + c.lane;
#pragma unroll
            for (int j = 0; j < 4; ++j) xo[64 * j] = v[j]; }
        const float rstd = rsqrtf(wave_sum(ss) * (1.f / DM) + RMS_EPS);
        const int rb = tp < CTXL ? 8 : b;
        const float* mrow = c_MOD + (size_t)(l * 9 + rb) * NMODC + (which == 0 ? 0 : 3 * DM);
        unsigned long long* o8 = (unsigned long long*)(c_ACT + (size_t)R * DM) + c.lane;
#pragma unroll
        for (int j = 0; j < 4; ++j) { const int col = 4 * c.lane + 256 * j;
            const f32x4 gg = *(const f32x4*)(g + col), sh = *(const f32x4*)(mrow + col), sc = *(const f32x4*)(mrow + DM + col);
            const float y0 = v[j].x * rstd * gg.x * (1.f + sc.x) + sh.x, y1 = v[j].y * rstd * gg.y * (1.f + sc.y) + sh.y;
            const float y2 = v[j].z * rstd * gg.z * (1.f + sc.z) + sh.z, y3 = v[j].w * rstd * gg.w * (1.f + sc.w) + sh.w;
            o8[64 * j] = (unsigned long long)pk2(y0, y1) | ((unsigned long long)pk2(y2, y3) << 32); }
    }
}

template <class Epi>
__device__ __forceinline__ void gemm_naive(const Ctx& c, const bf16* A, const bf16* Bt, int M, int N, int K, const Epi& E, bool skip_ctx) {
    const int nN = N / 32, nM = M / 64, r = c.lane & 31, h = c.lane >> 5;
    for (int u = c.gw; u < nM * nN; u += c.NGW) {
        const int mt = u / nN, nt = u - mt * nN, row0 = mt * 64, col0 = nt * 32;
        if (skip_ctx && (row0 % TPB) < CTXL) continue;
        const bf16* a0 = A + (size_t)(row0 + r) * K + 8 * h; const bf16* a1 = a0 + (size_t)32 * K; const bf16* b0 = Bt + (size_t)(col0 + r) * K + 8 * h;
        f32x16 c0, c1;
#pragma unroll
        for (int i = 0; i < 16; ++i) { c0[i] = 0.f; c1[i] = 0.f; }
#pragma unroll 4
        for (int k = 0; k < K; k += 16) {
            const bf16x8 fa0 = *(const bf16x8*)(a0 + k), fa1 = *(const bf16x8*)(a1 + k), fb = *(const bf16x8*)(b0 + k);
            c0 = __builtin_amdgcn_mfma_f32_32x32x16_bf16(fa0, fb, c0, 0, 0, 0);
            c1 = __builtin_amdgcn_mfma_f32_32x32x16_bf16(fa1, fb, c1, 0, 0, 0);
        }
        E(c0, row0, col0 + r, h); E(c1, row0 + 32, col0 + r, h);
    }
}
struct EpiInProj { bf16* P; float* G;
    __device__ __forceinline__ void operator()(const f32x16& a, int row0, int col, int h) const {
#pragma unroll
        for (int i = 0; i < 16; ++i) { const int row = row0 + (i & 3) + 8 * (i >> 2) + 4 * h;
            if (col < NP) P[(size_t)row * NP + col] = (bf16)f2bf(a[i]); else G[(size_t)row * 32 + (col - NP)] = a[i]; } } };
struct EpiGates { float* G;
    __device__ __forceinline__ void operator()(const f32x16& a, int row0, int col, int h) const {
#pragma unroll
        for (int i = 0; i < 16; ++i) { const int row = row0 + (i & 3) + 8 * (i >> 2) + 4 * h; G[(size_t)row * 32 + col] = a[i]; } } };
struct EpiResid { const Ctx* c; const float* gate;
    __device__ __forceinline__ void operator()(const f32x16& a, int row0, int col, int h) const {
#pragma unroll
        for (int i = 0; i < 16; ++i) { const int row = row0 + (i & 3) + 8 * (i >> 2) + 4 * h;
            float* xr = xs_row(*c, row); const float gt = gate[(size_t)mod_row(row) * NMODC + col]; xr[col] += gt * a[i]; } } };
struct EpiRelu2 { bf16* H;
    __device__ __forceinline__ void operator()(const f32x16& a, int row0, int col, int h) const {
#pragma unroll
        for (int i = 0; i < 16; ++i) { const int row = row0 + (i & 3) + 8 * (i >> 2) + 4 * h; const float v = fmaxf(a[i], 0.f); H[(size_t)row * DFF + col] = (bf16)f2bf(v * v); } } };

namespace pg8 {
#define PG8_LAS __attribute__((address_space(3)))
typedef unsigned short bf16_t;
typedef short bf16x8 __attribute__((ext_vector_type(8)));
typedef float f32x4 __attribute__((ext_vector_type(4)));
typedef unsigned u32x4 __attribute__((ext_vector_type(4)));
constexpr int BM = 256, BK = 64, HALF = 128, HTB = HALF * BK * 2  , STAGE_BYTES = 8 * HTB, NXCD = 8, WGM = 8;

__host__ __device__ __forceinline__ int lds_byte(int r, int c) { const int st = (r >> 4) * 2 + (c >> 5), rr = r & 15, cc = c & 31, ob = rr * 64 + cc * 2; return st * 1024 + (ob ^ (((ob >> 9) & 1) << 5)); }
__host__ __device__ __forceinline__ void stage_rc(int b, int& R, int& C) { const int st = b / 1024, sb = b % 1024, swz = sb ^ (((sb >> 9) & 1) << 5); R = (st >> 1) * 16 + swz / 64; C = (st & 1) * 32 + (swz % 64) / 2; }
__host__ __device__ __forceinline__ int perm32(int rho) { const int n = rho >> 4, i = rho & 15; return 8 * (i >> 2) + 4 * n + (i & 3); }

struct Unit { int pm, pn, koff; };
struct Gemm { const bf16_t* A; const bf16_t* Bt; int M, N, K, ld; };

struct StaticOrder {
    int nM, nN, nwg, G, c;
    __host__ __device__ void init(int M, int N, int G_, int c_) { nM = M / BM; nN = N / BM; nwg = nM * nN; G = G_; c = c_; }
    __host__ __device__ bool next(int i, Unit& u) const {
        const long L = (long)i * G + c; if (L >= nwg) return false;
        int wgid = (int)L; { const int q = nwg / NXCD, r = nwg % NXCD, xcd = wgid % NXCD, off = wgid / NXCD; wgid = (xcd < r ? xcd * (q + 1) : r * (q + 1) + (xcd - r) * q) + off; }
        const int nig = WGM * nN, gid = wgid / nig, fm = gid * WGM, gsz = (nM - fm) < WGM ? (nM - fm) : WGM;
        u.pm = fm + ((wgid % nig) % gsz); u.pn = (wgid % nig) / gsz; u.koff = 0; return true;
    }
    __device__ __forceinline__ void a_ready(const Unit&) const {}
    __device__ __forceinline__ void done(const Unit&) const {}
};

__device__ __forceinline__ unsigned cvt_pk_bf16(float lo, float hi) { unsigned r; asm volatile("v_cvt_pk_bf16_f32 %0, %1, %2" : "=v"(r) : "v"(lo), "v"(hi)); return r; }
template <int ACT  > struct EpiBf16 {
    static constexpr bool PERM = true, AFTER_DRAIN = false; static_assert(ACT == 0 || ACT == 2, "EpiBf16: ACT is 0 (none) or 2 (squared relu)");
    bf16_t* O; int ldc; const float* bias; int split_cols; size_t split_stride; float scale0;
    __device__ __forceinline__ void operator()(const f32x4 (&acc)[2][2][4][2], const Unit& u, int wr, int wc, int fr, int fq) const {
        const int row0 = u.pm * BM + wr * 64 + fr; int colt = u.pn * BM; bf16_t* base = O;
        float sc = 1.f; if (split_cols) { const int t = colt / split_cols; base += (size_t)t * split_stride; colt -= t * split_cols; if (t == 0) sc = scale0; }
        const int col0 = colt + wc * 32 + 8 * fq, bcol0 = u.pn * BM + wc * 32 + 8 * fq;
        f32x4 bv[2][2]; float zf_ = 0.f; asm volatile("" : "+v"(zf_)); const f32x4 z4_ = (f32x4){zf_, zf_, zf_, zf_};
#pragma unroll
        for (int bj = 0; bj < 2; ++bj)
#pragma unroll
            for (int n = 0; n < 2; ++n) bv[bj][n] = bias ? *(const f32x4*)(bias + bcol0 + bj * HALF + 4 * n) : z4_;
#pragma unroll
        for (int ai = 0; ai < 2; ++ai)
#pragma unroll
            for (int m = 0; m < 4; ++m) { bf16_t* rowp = base + (size_t)(row0 + ai * HALF + m * 16) * ldc + col0;
#pragma unroll
                for (int bj = 0; bj < 2; ++bj) { f32x4 v0 = acc[ai][bj][m][0] + bv[bj][0], v1 = acc[ai][bj][m][1] + bv[bj][1];
                    if (ACT == 2) { v0 = __builtin_elementwise_max(v0, z4_); v1 = __builtin_elementwise_max(v1, z4_); v0 = v0 * v0; v1 = v1 * v1; }
                    v0 = v0 * sc; v1 = v1 * sc; u32x4 w; w.x = cvt_pk_bf16(v0[0], v0[1]); w.y = cvt_pk_bf16(v0[2], v0[3]); w.z = cvt_pk_bf16(v1[0], v1[1]); w.w = cvt_pk_bf16(v1[2], v1[3]);
                    *(u32x4*)(rowp + bj * HALF) = w; } }
    }
};

struct EpiInProjG {
    static constexpr bool PERM = true, AFTER_DRAIN = false;
    bf16_t* P; float* G;
    __device__ __forceinline__ void operator()(const f32x4 (&acc)[2][2][4][2], const Unit& u, int wr, int wc, int fr, int fq) const {
        const int row0 = u.pm * BM + wr * 64 + fr;
        if (u.pn < 12) {
            const int col0 = u.pn * BM + wc * 32 + 8 * fq;
#pragma unroll
            for (int ai = 0; ai < 2; ++ai)
#pragma unroll
                for (int m = 0; m < 4; ++m) { bf16_t* rowp = P + (size_t)(row0 + ai * HALF + m * 16) * 3072 + col0;
#pragma unroll
                    for (int bj = 0; bj < 2; ++bj) { const f32x4 v0 = acc[ai][bj][m][0], v1 = acc[ai][bj][m][1];
                        u32x4 w; w.x = cvt_pk_bf16(v0[0], v0[1]); w.y = cvt_pk_bf16(v0[2], v0[3]); w.z = cvt_pk_bf16(v1[0], v1[1]); w.w = cvt_pk_bf16(v1[2], v1[3]);
                        *(u32x4*)(rowp + bj * HALF) = w; } }
        } else if (wc == 0) {
#pragma unroll
            for (int ai = 0; ai < 2; ++ai)
#pragma unroll
                for (int m = 0; m < 4; ++m) { float* gp = G + (size_t)(row0 + ai * HALF + m * 16) * 32 + 8 * fq; *(f32x4*)gp = acc[ai][0][m][0]; *(f32x4*)(gp + 4) = acc[ai][0][m][1]; }
        }
    }
};
struct EpiGateRes {
    static constexpr bool PERM = false, AFTER_DRAIN = false;
    float* xsc; float* out; const float* gate;
    __device__ __forceinline__ void operator()(const f32x4 (&acc)[2][2][4][2], const Unit& u, int wr, int wc, int fr, int fq) const {
        const int b = u.pm / 9, seg = u.pm - 9 * b;
        float* base = seg == 0 ? xsc + ((size_t)(b * 256) << 10) : out + ((size_t)(b * 2048 + (seg - 1) * 256) << 10);
        const float* grow = gate + (size_t)(seg == 0 ? 8 : b) * 6144;
        const int col0 = u.pn * BM + wc * 32 + 4 * fq;
        f32x4 gv[2][2];
#pragma unroll
        for (int bj = 0; bj < 2; ++bj)
#pragma unroll
            for (int n = 0; n < 2; ++n) gv[bj][n] = *(const f32x4*)(grow + col0 + bj * HALF + n * 16);
#pragma unroll
        for (int ai = 0; ai < 2; ++ai)
#pragma unroll
            for (int m = 0; m < 4; ++m) { float* rowp = base + (size_t)(ai * HALF + wr * 64 + m * 16 + fr) * 1024 + col0;
#pragma unroll
                for (int bj = 0; bj < 2; ++bj)
#pragma unroll
                    for (int n = 0; n < 2; ++n) { f32x4* p = (f32x4*)(rowp + bj * HALF + n * 16); *p = *p + gv[bj][n] * acc[ai][bj][m][n]; }
                if (m & 1) asm volatile("" ::: "memory"); }
    }
};
struct CtxSplitOrder {
    int G, c, NS, kslice;
    __device__ void init(int G_, int c_, int NS_, int K) { G = G_; c = c_; NS = NS_; kslice = K / NS_; }
    __device__ bool next(int i, Unit& u) const { const int L = i * G + c; if (L >= 32 * NS) return false; const int t = L / NS, ks = L - t * NS; u.pm = 9 * (t >> 2); u.pn = t & 3; u.koff = ks * kslice; return true; }
    __device__ __forceinline__ void a_ready(const Unit&) const {}
    __device__ __forceinline__ void done(const Unit&) const {}
};
struct EpiSlab {
    static constexpr bool PERM = false, AFTER_DRAIN = false;
    float* slab; int NS, kslice;
    __device__ __forceinline__ void operator()(const f32x4 (&acc)[2][2][4][2], const Unit& u, int wr, int wc, int fr, int fq) const {
        float* base = slab + ((size_t)(((u.pm / 9) * 4 + u.pn) * NS + u.koff / kslice) << 16);
        const int col0 = wc * 32 + 4 * fq;
#pragma unroll
        for (int ai = 0; ai < 2; ++ai)
#pragma unroll
            for (int m = 0; m < 4; ++m) { float* rowp = base + (ai * HALF + wr * 64 + m * 16 + fr) * 256 + col0;
#pragma unroll
                for (int bj = 0; bj < 2; ++bj)
#pragma unroll
                    for (int n = 0; n < 2; ++n) *(f32x4*)(rowp + bj * HALF + n * 16) = acc[ai][bj][m][n]; }
    }
};
struct RowOrder {
    StaticOrder so; bool lat_only;
    __device__ void init(int N, int G_, int c_, bool lat) { lat_only = lat; so.init(lat ? 16384 : 18432, N, G_, c_); }
    __device__ bool next(int i, Unit& u) const { if (!so.next(i, u)) return false; if (lat_only) u.pm = 9 * (u.pm >> 3) + 1 + (u.pm & 7); return true; }
    __device__ __forceinline__ void a_ready(const Unit&) const {}
    __device__ __forceinline__ void done(const Unit&) const {}
};
template <class Epi, class Sched, bool ALIGN_EPI = false, bool SP2 = false>
__device__ __forceinline__ void gemm_phase(PG8_LAS unsigned char* lds, const Gemm g, const Sched& S, const Epi& E, const int tid) {
    const int wid = __builtin_amdgcn_readfirstlane(tid >> 6), lane = tid & 63, wr = wid >> 2, wc = wid & 3, fr = lane & 15, fq = lane >> 4;
    const int K = g.ld, nt = g.K / BK;
    float zf_ = 0.f; asm volatile("" : "+v"(zf_));
    unsigned voffA[2], voffB[2];
#pragma unroll
    for (int i = 0; i < 2; ++i) { int R, C; stage_rc(tid * 16 + i * 8192, R, C); const int Rb = Epi::PERM ? ((R & ~31) + perm32(R & 31)) : R;
        voffA[i] = (unsigned)(R * K + C) * 2u; voffB[i] = (unsigned)(Rb * K + C) * 2u; }
    const size_t kstep = (size_t)(BK * 2);
    const size_t hstep = (size_t)HALF * K * 2;
    const size_t tstep = 2 * hstep;
    const unsigned ldsw = (unsigned)wid * 1024u;
    const int aoff = lds_byte(wr * 64 + fr, fq * 8), boff = lds_byte(wc * 32 + fr, fq * 8);
#define PG8_SA(b, h) (((b) * 2 + (h)) * HTB)
#define PG8_SB(b, h) ((4 + (b) * 2 + (h)) * HTB)
#define PG8_STAGE(bufoff, gbase, voff) do { _Pragma("unroll") for (int _i = 0; _i < 2; ++_i) \
        __builtin_amdgcn_global_load_lds((const unsigned*)((const char*)(gbase) + (voff)[_i]), (PG8_LAS unsigned*)(lds + (bufoff) + ldsw + _i * 8192), 16, 0, 0); } while (0)
#define PG8_LDA(dst, b, h) do { _Pragma("unroll") for (int m = 0; m < 4; ++m) _Pragma("unroll") for (int k = 0; k < 2; ++k) dst[m][k] = *(const PG8_LAS bf16x8*)(lds + PG8_SA(b, h) + aoff + m * 2048 + k * 1024); } while (0)
#define PG8_LDB(dst, b, h) do { _Pragma("unroll") for (int n = 0; n < 2; ++n) _Pragma("unroll") for (int k = 0; k < 2; ++k) dst[n][k] = *(const PG8_LAS bf16x8*)(lds + PG8_SB(b, h) + boff + n * 2048 + k * 1024); } while (0)
#define PG8_MMA(ai, bj, At, Bt) do { __builtin_amdgcn_s_setprio(1); _Pragma("unroll") for (int m = 0; m < 4; ++m) _Pragma("unroll") for (int n = 0; n < 2; ++n) _Pragma("unroll") for (int k = 0; k < 2; ++k) \
        acc[ai][bj][m][n] = __builtin_amdgcn_mfma_f32_16x16x32_bf16(Bt[n][k], At[m][k], acc[ai][bj][m][n], 0, 0, 0); __builtin_amdgcn_s_setprio(0); } while (0)
#define PG8_WAIT_V(n) asm volatile("s_waitcnt vmcnt(" #n ")" ::: "memory")
#define PG8_WAIT_L(n) asm volatile("s_waitcnt lgkmcnt(" #n ")" ::: "memory")
#define PG8_BAR __builtin_amdgcn_s_barrier()
#define PG8_SCHED __builtin_amdgcn_sched_barrier(0)
    Unit cur, nxt; int ui = 0;
    if (!S.next(0, cur)) return;
    f32x4 acc[2][2][4][2];
#pragma unroll
    for (int a = 0; a < 2; ++a)
#pragma unroll
        for (int b = 0; b < 2; ++b)
#pragma unroll
            for (int m = 0; m < 4; ++m)
#pragma unroll
                for (int n = 0; n < 2; ++n) acc[a][b][m][n] = (f32x4){zf_, zf_, zf_, zf_};
    bf16x8 At[4][2], B0[2][2], B1[2][2];
    const char* cA = (const char*)g.A + (size_t)cur.pm * tstep + (size_t)cur.koff * 2; const char* cB = (const char*)g.Bt + (size_t)cur.pn * tstep + (size_t)cur.koff * 2;
    S.a_ready(cur);
    if constexpr (SP2) {
        PG8_STAGE(PG8_SB(0, 0), cB, voffB); PG8_STAGE(PG8_SB(0, 1), cB + hstep, voffB); PG8_STAGE(PG8_SA(0, 0), cA, voffA); PG8_STAGE(PG8_SA(0, 1), cA + hstep, voffA);
        if (wr == 1) PG8_BAR;
        PG8_WAIT_V(2); PG8_BAR;
        PG8_STAGE(PG8_SB(1, 0), cB + kstep, voffB); PG8_STAGE(PG8_SA(1, 0), cA + kstep, voffA); PG8_STAGE(PG8_SB(1, 1), cB + hstep + kstep, voffB);
        PG8_WAIT_V(6); PG8_BAR;
    } else {
        PG8_STAGE(PG8_SB(0, 0), cB, voffB); PG8_STAGE(PG8_SA(0, 0), cA, voffA); PG8_STAGE(PG8_SB(0, 1), cB + hstep, voffB); PG8_STAGE(PG8_SA(0, 1), cA + hstep, voffA);
        if (wr == 1) PG8_BAR;
        PG8_WAIT_V(4); PG8_BAR;
        PG8_STAGE(PG8_SB(1, 0), cB + kstep, voffB); PG8_STAGE(PG8_SA(1, 0), cA + kstep, voffA); PG8_STAGE(PG8_SB(1, 1), cB + hstep + kstep, voffB);
        PG8_WAIT_V(6); PG8_BAR;
    }
    for (;;) {
        const bool has_next = S.next(ui + 1, nxt);
        const char* nA = has_next ? (const char*)g.A + (size_t)nxt.pm * tstep + (size_t)nxt.koff * 2 : cA; const char* nB = has_next ? (const char*)g.Bt + (size_t)nxt.pn * tstep + (size_t)nxt.koff * 2 : cB;
        for (int t = 0; t < nt; t += 2) {
            const bool last = (t == nt - 2);
            const char* a1 = cA + (size_t)(t + 1) * kstep;
            const char* a2 = last ? nA : cA + (size_t)(t + 2) * kstep; const char* b2 = last ? nB : cB + (size_t)(t + 2) * kstep;
            const char* a3 = a2 + kstep; const char* b3 = b2 + kstep;
            if (last && has_next) S.a_ready(nxt);
            if constexpr (SP2) {
            PG8_LDB(B0, 0, 0); PG8_LDB(B1, 0, 1); PG8_SCHED; PG8_LDA(At, 0, 0); PG8_STAGE(PG8_SA(1, 1), a1 + hstep, voffA);
            PG8_WAIT_V(8); PG8_WAIT_L(0); PG8_BAR; PG8_MMA(0, 0, At, B0); PG8_MMA(0, 1, At, B1); PG8_BAR; PG8_SCHED;
            PG8_LDA(At, 0, 1); PG8_STAGE(PG8_SB(0, 0), b2, voffB); PG8_STAGE(PG8_SB(0, 1), b2 + hstep, voffB); PG8_STAGE(PG8_SA(0, 0), a2, voffA);
            PG8_WAIT_V(8); PG8_WAIT_L(0); PG8_BAR; PG8_MMA(1, 0, At, B0); PG8_MMA(1, 1, At, B1); PG8_BAR; PG8_SCHED;
            PG8_LDB(B0, 1, 0); PG8_LDB(B1, 1, 1); PG8_SCHED; PG8_LDA(At, 1, 0); PG8_STAGE(PG8_SA(0, 1), a2 + hstep, voffA);
            PG8_WAIT_V(8); PG8_WAIT_L(0); PG8_BAR; PG8_MMA(0, 0, At, B0); PG8_MMA(0, 1, At, B1); PG8_BAR; PG8_SCHED;
            PG8_LDA(At, 1, 1); PG8_STAGE(PG8_SB(1, 0), b3, voffB); PG8_STAGE(PG8_SB(1, 1), b3 + hstep, voffB); PG8_STAGE(PG8_SA(1, 0), a3, voffA);
            PG8_WAIT_V(8); PG8_WAIT_L(0); PG8_BAR; PG8_MMA(1, 0, At, B0); PG8_MMA(1, 1, At, B1); PG8_BAR; PG8_SCHED;
            } else {
            PG8_LDB(B0, 0, 0); PG8_SCHED; PG8_LDA(At, 0, 0); PG8_STAGE(PG8_SA(1, 1), a1 + hstep, voffA);
            PG8_WAIT_L(8); PG8_BAR; PG8_WAIT_L(0); PG8_MMA(0, 0, At, B0); PG8_BAR; PG8_SCHED;
            PG8_LDB(B1, 0, 1); PG8_STAGE(PG8_SB(0, 0), b2, voffB);
            PG8_BAR; PG8_WAIT_L(0); PG8_MMA(0, 1, At, B1); PG8_BAR;
            PG8_LDA(At, 0, 1); PG8_STAGE(PG8_SA(0, 0), a2, voffA);
            PG8_BAR; PG8_WAIT_L(0); PG8_MMA(1, 0, At, B0); PG8_BAR; PG8_SCHED;
            PG8_STAGE(PG8_SB(0, 1), b2 + hstep, voffB);
            PG8_WAIT_V(6); PG8_BAR; PG8_MMA(1, 1, At, B1); PG8_BAR;
            PG8_LDB(B0, 1, 0); PG8_SCHED; PG8_LDA(At, 1, 0); PG8_STAGE(PG8_SA(0, 1), a2 + hstep, voffA);
            PG8_WAIT_L(8); PG8_BAR; PG8_WAIT_L(0); PG8_MMA(0, 0, At, B0); PG8_BAR; PG8_SCHED;
            PG8_LDB(B1, 1, 1); PG8_STAGE(PG8_SB(1, 0), b3, voffB);
            PG8_BAR; PG8_WAIT_L(0); PG8_MMA(0, 1, At, B1); PG8_BAR;
            PG8_LDA(At, 1, 1); PG8_STAGE(PG8_SA(1, 0), a3, voffA);
            PG8_BAR; PG8_WAIT_L(0); PG8_MMA(1, 0, At, B0); PG8_BAR; PG8_SCHED;
            PG8_STAGE(PG8_SB(1, 1), b3 + hstep, voffB);
            PG8_WAIT_V(6); PG8_BAR; PG8_MMA(1, 1, At, B1); PG8_BAR;
            }
        }
        if constexpr (ALIGN_EPI) { if (wr == 0) PG8_BAR; }
        if constexpr (!Epi::AFTER_DRAIN) { E(acc, cur, wr, wc, fr, fq); S.done(cur); }
        if (!has_next) break;
#pragma unroll
        for (int a = 0; a < 2; ++a)
#pragma unroll
            for (int b = 0; b < 2; ++b)
#pragma unroll
                for (int m = 0; m < 4; ++m)
#pragma unroll
                    for (int n = 0; n < 2; ++n) acc[a][b][m][n] = (f32x4){zf_, zf_, zf_, zf_};
        cur = nxt; cA = nA; cB = nB; ++ui;
        if constexpr (ALIGN_EPI) { if (wr == 1) PG8_BAR; }
    }
    PG8_WAIT_V(0);
    if constexpr (!ALIGN_EPI) { if (wr == 0) PG8_BAR; }
    PG8_BAR;
    if constexpr (Epi::AFTER_DRAIN) { E.fused(acc, cur, wr, wc, fr, fq, lds, wid, lane); S.done(cur); }
#undef PG8_SA
#undef PG8_SB
#undef PG8_STAGE
#undef PG8_LDA
#undef PG8_LDB
#undef PG8_MMA
#undef PG8_WAIT_V
#undef PG8_WAIT_L
#undef PG8_BAR
#undef PG8_SCHED
}
}

__device__ __forceinline__ void attn_prep_phase(Ctx& c, int l, const bool dry = false) {
    const float* gq_b = c_in(12) + l * 64; const float* gk_b = c_in(13) + l * 64; const float* gq_c = c_in(14) + l * 64; const float* gk_c = c_in(15) + l * 64;
    const float* rope = c_ROPE; bf16* P = c_P; const int lane = c.lane;
    for (int it = c.gw; it < NT / 2; it += c.NGW) {
        bf16x8 raw[3];
#pragma unroll
        for (int k = 0; k < 3; ++k) { const int ch = lane + 64 * k, row = ch >= 96, cr = ch - 96 * row, rng = cr >= 48, cc = cr - 48 * rng;
            raw[k] = *(const bf16x8*)(P + (size_t)(2 * it + row) * NP + (rng ? PC_C : PC_B) + cc * 8); }
#pragma unroll
        for (int k = 0; k < 3; ++k) { const int ch = lane + 64 * k, row = ch >= 96, cr = ch - 96 * row, rng = cr >= 48, cc = cr - 48 * rng, jj = cc >> 3, p = cc & 7;
            const int R = 2 * it + row; const int tp = R % TPB; const bool isq = jj < 4;
            const float* gn = (rng ? (isq ? gq_c : gk_c) : (isq ? gq_b : gk_b)) + 8 * p;
            float x[8], ss = 0.f;
#pragma unroll
            for (int e = 0; e < 8; ++e) { x[e] = bfs2f(raw[k][e]); ss += x[e] * x[e]; }
            ss += lane_xor(ss, 1, lane); ss += lane_xor(ss, 2, lane); ss += lane_xor(ss, 4, lane);
            const float rstd = rsqrtf(ss * (1.f / 64.f) + RMS_EPS);
            const f32x4 g0 = *(const f32x4*)gn, g1 = *(const f32x4*)(gn + 4);
            float y[8];
#pragma unroll
            for (int e = 0; e < 8; ++e) y[e] = x[e] * rstd * (e < 4 ? g0[e] : g1[e - 4]);
            if (tp >= CTXL) { const int t = tp - CTXL; const int pos = p < 4 ? (t >> 6) : 32 + (t & 63);
                const float* rt = rope + 2 * (pos * 16 + 8 * (p & 1));
                const f32x4 r0 = *(const f32x4*)rt, r1 = *(const f32x4*)(rt + 4), r2 = *(const f32x4*)(rt + 8), r3 = *(const f32x4*)(rt + 12);
                const float cs[8] = {r0[0], r0[2], r1[0], r1[2], r2[0], r2[2], r3[0], r3[2]}, sn[8] = {r0[1], r0[3], r1[1], r1[3], r2[1], r2[3], r3[1], r3[3]};
#pragma unroll
                for (int e = 0; e < 8; ++e) { const float partner = lane_xor(y[e], 2, lane); y[e] = (p & 2) ? (y[e] * cs[e] + partner * sn[e]) : (y[e] * cs[e] - partner * sn[e]); } }
            const float sc = isq ? C2 : 1.f;
            v4u o; o.x = pk2(y[0] * sc, y[1] * sc); o.y = pk2(y[2] * sc, y[3] * sc); o.z = pk2(y[4] * sc, y[5] * sc); o.w = pk2(y[6] * sc, y[7] * sc);
            if (dry) o = __builtin_bit_cast(v4u, raw[k]);
            *(v4u*)(P + (size_t)R * NP + (rng ? PC_C : PC_B) + cc * 8) = o; }
    }
}

__device__ __forceinline__ void gdn_naive_unit(Ctx& c, int l, int u, LAS float* kq  ) {
    const int d = u & 1, h = (u >> 1) & 7, b = u >> 4, lane = c.lane;
    const float* cw = c_in(8) + (size_t)l * 5 * 1536;
    LAS float* wts = kq + 128;
#pragma unroll
    for (int j = 0; j < 5; ++j) { wts[(3 * j) * 64 + lane] = cw[j * 1536 + h * 64 + lane]; wts[(3 * j + 1) * 64 + lane] = cw[j * 1536 + 512 + h * 64 + lane]; wts[(3 * j + 2) * 64 + lane] = cw[j * 1536 + 1024 + h * 64 + lane]; }
    LDS_WAIT(); asm volatile("" ::: "memory");
    const float Aexp = __expf(c_in(9)[l * 16 + d * 8 + h]), dtb = c_in(10)[l * 16 + d * 8 + h];
    float S[64];
#pragma unroll
    for (int i = 0; i < 64; ++i) S[i] = 0.f;
    float* og = c_OG + (size_t)d * NT * 512;
    for (int seg = 0; seg < 2; ++seg) {
        const int len = seg ? SEQ : CTXL, base = b * TPB + (seg ? CTXL : 0);
        for (int i = 0; i < len; ++i) {
            const int t = d ? len - 1 - i : i; const int R = base + t;
            float qc = 0.f, kc = 0.f, vc = 0.f;
#pragma unroll
            for (int j = 0; j < 5; ++j) { const int tt = t + j - 2;
                if (tt >= 0 && tt < len) { const bf16* pr = c_P + (size_t)(base + tt) * NP + h * 64 + lane;
                    qc += wts[(3 * j) * 64 + lane] * bf2f(pr[0]); kc += wts[(3 * j + 1) * 64 + lane] * bf2f(pr[512]); vc += wts[(3 * j + 2) * 64 + lane] * bf2f(pr[1024]); } }
            qc = siluf(qc); kc = siluf(kc); vc = siluf(vc);
            const float q = qc * rsqrtf(wave_sum(qc * qc) + 1e-6f) * 0.125f, k = kc * rsqrtf(wave_sum(kc * kc) + 1e-6f);
            const float braw = c_Gt[(size_t)R * 32 + d * 8 + h], araw = c_Gt[(size_t)R * 32 + 16 + d * 8 + h] + dtb;
            const float beta = 1.f / (1.f + __expf(-braw));
            const float sp = araw > 20.f ? araw : log1pf(__expf(araw));
            const float a = __expf(-Aexp * sp);
            kq[lane] = k; kq[64 + lane] = q;
            LDS_WAIT(); asm volatile("" ::: "memory");
            float kS = 0.f;
#pragma unroll
            for (int i2 = 0; i2 < 64; ++i2) { S[i2] *= a; kS += kq[i2] * S[i2]; }
            const float vn = beta * (vc - kS);
            float o = 0.f;
#pragma unroll
            for (int i2 = 0; i2 < 64; ++i2) { S[i2] += kq[i2] * vn; o += kq[64 + i2] * S[i2]; }
            og[(size_t)R * 512 + h * 64 + lane] = o;
            LDS_WAIT(); asm volatile("" ::: "memory");
        }
    }
}

__device__ __forceinline__ void attn_naive_unit(Ctx& c, int l, int u, LAS float* sc  ) {
    const int typ = u & 1, hq = (u >> 1) & 3, R = u >> 3; const int lane = c.lane;
    const int b = R / TPB, tp = R - b * TPB; const bool isctx = tp < CTXL;
    if (isctx && l == NL - 1) return;
    const int pc = typ ? PC_C : PC_B, hkv = hq >> 1;
    const int tq = tp - CTXL;
    LAS float* qs = sc + 2304;
    qs[lane] = bf2f(c_P[(size_t)R * NP + pc + hq * 64 + lane]);
    LDS_WAIT(); asm volatile("" ::: "memory");
    float qv[64];
#pragma unroll
    for (int i = 0; i < 64; ++i) qv[i] = qs[i];
    int lo = CTXL, hi = CTXL;
    if (!isctx) { if (typ == 0) { lo = CTXL; hi = TPB; } else { lo = CTXL + (tq - 128 > 0 ? tq - 128 : 0); hi = CTXL + (tq + 128 < SEQ - 1 ? tq + 128 : SEQ - 1) + 1; } }
    const int nkA = CTXL, nkB = hi - lo, nk = nkA + nkB;
    const bf16* Kb = c_P + (size_t)b * TPB * NP + pc + 256 + hkv * 64;
    const bf16* Vb = Kb + 128;
    float mx = -INFINITY;
    for (int j0 = 0; j0 < nk; j0 += 64) {
        const int j = j0 + lane; float s = -INFINITY;
        if (j < nk) { const int kr = j < nkA ? j : lo + (j - nkA); const bf16x8* kp = (const bf16x8*)(Kb + (size_t)kr * NP); s = 0.f;
#pragma unroll
            for (int q8 = 0; q8 < 8; ++q8) { const bf16x8 kk = kp[q8];
#pragma unroll
                for (int e = 0; e < 8; ++e) s += qv[q8 * 8 + e] * bfs2f(kk[e]); } }
        sc[j] = s; mx = fmaxf(mx, s);
    }
    mx = wave_max(mx);
    float sinkl = 0.f;
    if (typ) { sinkl = c_in(16)[l * 4 + hq] * LOG2E; mx = fmaxf(mx, sinkl); }
    LDS_WAIT(); asm volatile("" ::: "memory");
    float lsum = 0.f;
    for (int j0 = 0; j0 < nk; j0 += 64) { const int j = j0 + lane; float p = 0.f; if (j < nk) p = exp2f(sc[j] - mx); sc[j] = p; lsum += p; }
    lsum = wave_sum(lsum);
    if (typ) lsum += exp2f(sinkl - mx);
    LDS_WAIT(); asm volatile("" ::: "memory");
    float o = 0.f;
    for (int j = 0; j < nkA; ++j) o += sc[j] * bf2f(Vb[(size_t)j * NP + lane]);
    for (int j = 0; j < nkB; ++j) o += sc[nkA + j] * bf2f(Vb[(size_t)(lo + j) * NP + lane]);
    c_ACT[(size_t)R * DM + 512 + typ * 256 + hq * 64 + lane] = (bf16)f2bf(o / lsum);
    LDS_WAIT(); asm volatile("" ::: "memory");
}
__device__ __forceinline__ void mixer_naive_phase(Ctx& c, int l) {
    LAS float* wl = (LAS float*)c.lds + c.wave * 2432;
    const bool gdn_wave = (c.wave == 0 && c.bx < 128);
    if (gdn_wave) { gdn_naive_unit(c, l, c.bx, wl); return; }
    const int aw = c.bx * NWAVES + c.wave - (c.bx < 128 ? c.bx + 1 : 128);
    const int NAW = c.G * NWAVES - (c.G < 128 ? c.G : 128);
    for (int u = aw; u < NT * 8; u += NAW) attn_naive_unit(c, l, u, wl);
}

#ifndef ATTN_STORE16
#define ATTN_STORE16(p,v) (*(u32x4*)(p)=(v))
#endif
namespace attn_body {
using bf16=unsigned short;
using bf16x8=__attribute__((ext_vector_type(8)))short;
using s16x4=__attribute__((ext_vector_type(4)))short;
using f32x16=__attribute__((ext_vector_type(16)))float;
using u32x4=__attribute__((ext_vector_type(4)))unsigned;
constexpr int D=64,QP=3072,OP=1024;
constexpr int NW=8,QBLK=32,QB=QBLK*NW,KVBLK=64;
__device__ __forceinline__ int crow(int r,int hi){return (r&3)+8*(r>>2)+4*hi;}
#define SBAR() __builtin_amdgcn_sched_barrier(0)
__device__ __forceinline__ void wmask(f32x16&p0,f32x16&p1,int rel,int hi){
  const float NEG=-INFINITY; const int kb=rel+4*hi;
  #pragma unroll
  for(int r=0;r<16;++r){const int kv=kb+(r&3)+8*(r>>2); if(kv>128||kv<-128)p0[r]=NEG; if(kv+32>128||kv+32<-128)p1[r]=NEG;}
}

constexpr int NSLOT=3, SLOTB=8192;
constexpr int LDS_K=0, LDS_V=NSLOT*SLOTB, LDS_WS=2*NSLOT*SLOTB, LDS_OST=LDS_WS+NW*64*4, LDS_BYTES=LDS_OST+NW*4096;
constexpr float C2=0.125f*1.4426950408889634f;
__device__ __forceinline__ void glds16(const void*gsrc,unsigned lds_dst){unsigned keep;
  asm volatile("s_mov_b32 %0, m0\n\ts_mov_b32 m0, %2\n\ts_nop 0\n\tglobal_load_lds_dwordx4 %1, off\n\ts_mov_b32 m0, %0":"=&s"(keep):"v"(gsrc),"s"(lds_dst):"memory");}
__device__ __forceinline__ float max3f(float a,float b,float c){float r;asm("v_max3_f32 %0, %1, %2, %3":"=v"(r):"v"(a),"v"(b),"v"(c));return r;}
__device__ __forceinline__ float max2f(float a,float b){float r;asm("v_max_f32_e32 %0, %1, %2":"=v"(r):"v"(a),"v"(b));return r;}
__device__ __forceinline__ float fadd_s(float a,float b){float r;asm("v_add_f32_e32 %0, %1, %2":"=v"(r):"v"(a),"v"(b));return r;}
__device__ __forceinline__ float fsub_s(float a,float b){float r;asm("v_sub_f32_e32 %0, %1, %2":"=v"(r):"v"(a),"v"(b));return r;}
typedef float f32x2_t __attribute__((ext_vector_type(2))); typedef __bf16 bf16x2_t __attribute__((ext_vector_type(2)));
__device__ __forceinline__ unsigned cvtpk_s(float lo,float hi){f32x2_t v={lo,hi};bf16x2_t b=__builtin_convertvector(v,bf16x2_t);return __builtin_bit_cast(unsigned,b);}
#define WAIT_BAR(N) asm volatile("s_waitcnt vmcnt(" #N ") lgkmcnt(0)\n\ts_barrier":::"memory")

__device__ __forceinline__ void qkt(f32x16&p0,f32x16&p1,const char*Kslot,const bf16x8*qr,const f32x16&negm,int r32,int hi){
  const char*kb=Kslot+hi*1024+r32*16;
  #pragma unroll
  for(int d0=0;d0<4;++d0){
    const bf16x8 b0=*reinterpret_cast<const bf16x8*>(kb+d0*2048);
    const bf16x8 b1=*reinterpret_cast<const bf16x8*>(kb+d0*2048+512);
    if(d0==0){p0=__builtin_amdgcn_mfma_f32_32x32x16_bf16(b0,qr[0],negm,0,0,0);p1=__builtin_amdgcn_mfma_f32_32x32x16_bf16(b1,qr[0],negm,0,0,0);}
    else{p0=__builtin_amdgcn_mfma_f32_32x32x16_bf16(b0,qr[d0],p0,0,0,0);p1=__builtin_amdgcn_mfma_f32_32x32x16_bf16(b1,qr[d0],p1,0,0,0);}}
}
typedef __attribute__((address_space(3))) const char* lds_cptr;
typedef short v4i16_t __attribute__((ext_vector_type(4)));
__device__ __forceinline__ void kload8(bf16x8*kf,lds_cptr kp){
  kf[0]=*(const __attribute__((address_space(3))) bf16x8*)(kp);      kf[1]=*(const __attribute__((address_space(3))) bf16x8*)(kp+512);
  kf[2]=*(const __attribute__((address_space(3))) bf16x8*)(kp+2048); kf[3]=*(const __attribute__((address_space(3))) bf16x8*)(kp+2560);
  kf[4]=*(const __attribute__((address_space(3))) bf16x8*)(kp+4096); kf[5]=*(const __attribute__((address_space(3))) bf16x8*)(kp+4608);
  kf[6]=*(const __attribute__((address_space(3))) bf16x8*)(kp+6144); kf[7]=*(const __attribute__((address_space(3))) bf16x8*)(kp+6656);
}
__device__ __forceinline__ void kload2(bf16x8*kf,lds_cptr kp,int j){ kf[2*j]=*(const __attribute__((address_space(3))) bf16x8*)(kp+j*2048); kf[2*j+1]=*(const __attribute__((address_space(3))) bf16x8*)(kp+j*2048+512); }
__device__ __forceinline__ s16x4 vtr(lds_cptr p){ return __builtin_bit_cast(s16x4,__builtin_amdgcn_ds_read_tr16_b64_v4i16((__attribute__((address_space(3))) v4i16_t*)p)); }
__device__ __forceinline__ float rowmax(const f32x16&p0,const f32x16&p1){
  float a=max3f(p0[0],p0[1],p1[0]),b=max3f(p0[2],p0[3],p1[1]);a=max3f(a,p1[2],p1[3]);
  #pragma unroll
  for(int r=4;r<16;r+=4){a=max3f(a,p0[r],p0[r+1]);b=max3f(b,p0[r+2],p0[r+3]);a=max3f(a,p1[r],p1[r+1]);b=max3f(b,p1[r+2],p1[r+3]);}
  const float m=max2f(a,b);
  auto rr=__builtin_amdgcn_permlane32_swap(__float_as_uint(m),__float_as_uint(m),false,false);
  return max2f(__uint_as_float(rr[0]),__uint_as_float(rr[1]));
}
__device__ __forceinline__ void pv(f32x16*o,int vb,bf16x8 pa0,bf16x8 pa1,bf16x8 pa2,bf16x8 pa3){
  #pragma unroll
  for(int d0=0;d0<2;++d0){s16x4 lo[4],hi[4];
    #pragma unroll
    for(int ks=0;ks<4;++ks){
      asm volatile("ds_read_b64_tr_b16 %0,%1 offset:%c2":"=&v"(lo[ks]):"v"(vb),"i"(d0*4096+ks*1024):"memory");
      asm volatile("ds_read_b64_tr_b16 %0,%1 offset:%c2":"=&v"(hi[ks]):"v"(vb),"i"(d0*4096+ks*1024+512):"memory");}
    asm volatile("s_waitcnt lgkmcnt(0)":::"memory");SBAR();
    #define PK(k) (bf16x8){lo[k][0],lo[k][1],lo[k][2],lo[k][3],hi[k][0],hi[k][1],hi[k][2],hi[k][3]}
    o[d0]=__builtin_amdgcn_mfma_f32_32x32x16_bf16(pa0,PK(0),o[d0],0,0,0);
    o[d0]=__builtin_amdgcn_mfma_f32_32x32x16_bf16(pa1,PK(1),o[d0],0,0,0);
    o[d0]=__builtin_amdgcn_mfma_f32_32x32x16_bf16(pa2,PK(2),o[d0],0,0,0);
    o[d0]=__builtin_amdgcn_mfma_f32_32x32x16_bf16(pa3,PK(3),o[d0],0,0,0);
    #undef PK
  }
}

#ifndef ATTN_STORE16
#define ATTN_STORE16(p,v) (*(u32x4*)(p)=(v))
#endif
template<int THRL> __device__ __forceinline__ void attn_unit(const bf16*Qrow0,const bf16*__restrict__ Kh,const bf16*__restrict__ Vh,bf16*Orow0,const int NT,const int woff,const int kq0,const float sinkl,const bool has_sink,const bool domask,char*shm,const int tid){
  const int lane=tid&63,r32=lane&31,hi=lane>>5; const int wid=__builtin_amdgcn_readfirstlane(tid>>6);
  const bf16*Qw=Qrow0+(long)(wid*QBLK)*QP;
  const unsigned lds0=(unsigned)(uintptr_t)shm;
  float*wsf=(float*)(shm+LDS_WS)+wid*64;
  const bf16*ksrc=Kh+(long)lane*QP+wid*8;
  const bf16*vsrc=Vh+(long)(16*(wid&3)+(lane>>2))*QP+(wid>>2)*32+(lane&3)*8;
  const unsigned kdst=lds0+LDS_K+wid*1024, vdst=lds0+LDS_V+wid*1024;
  #define KROW(t) (KVBLK*(t)+(((t)>=4)?woff:0))
  #define DMA_K(t,slot) glds16(ksrc+(long)KROW(t)*QP,(unsigned)__builtin_amdgcn_readfirstlane(kdst+(slot)))
  #define DMA_V(t,slot) glds16(vsrc+(long)KROW(t)*QP,(unsigned)__builtin_amdgcn_readfirstlane(vdst+(slot)))
  const int vb0=(int)(lds0+LDS_V)+((lane>>4)&1)*32+(lane&3)*8+(4*hi+((lane&15)>>2))*64;
  const char*Kbase=shm+LDS_K; bf16x8 kf[8];
  const lds_cptr shm3=(lds_cptr)shm; const lds_cptr kp0=shm3+LDS_K+hi*1024+r32*16; const lds_cptr vp0=shm3+LDS_V+((lane>>4)&1)*32+(lane&3)*8+(4*hi+((lane&15)>>2))*64;
  DMA_K(0,0);DMA_V(0,0);DMA_K(1,SLOTB);
  bf16x8 qr[4];
  #pragma unroll
  for(int d0=0;d0<4;++d0)qr[d0]=*reinterpret_cast<const bf16x8*>(&Qw[(long)r32*QP+d0*16+hi*8]);
  float mhat=0.f,l_reg=0.f;f32x16 o[2];o[0]=f32x16{};o[1]=f32x16{};f32x16 negm=f32x16{};asm volatile("":"+v"(negm));
  const int qrel=wid*QBLK+r32;
  #define CMASK(P0,P1,t) do{ if(domask&&(t)>=4) wmask(P0,P1,kq0+KVBLK*(t)-qrel,hi); }while(0)
  bool resc=false;
  #define START(P0,P1) do{ const float rm=rowmax(P0,P1); resc=false; \
    { const float dl=rm; mhat=fadd_s(mhat,dl); \
      _Pragma("unroll") for(int r=0;r<16;++r){P0[r]=fsub_s(P0[r],dl);P1[r]=fsub_s(P1[r],dl);} \
      _Pragma("unroll") for(int r=0;r<16;++r)negm[r]=-mhat; asm volatile("":"+v"(negm)); } \
    _Pragma("unroll") for(int r=0;r<16;++r)P0[r]=__builtin_amdgcn_exp2f(P0[r]); }while(0)
  #define RESC() do{ if(resc){ asm volatile("s_waitcnt lgkmcnt(0)":::"memory"); \
      _Pragma("unroll") for(int d_=0;d_<2;++d_) _Pragma("unroll") for(int r=0;r<16;++r)o[d_][r]*=wsf[crow(r,hi)]; } }while(0)
  f32x16 pA0,pA1,pB0,pB1;
  int sl_prev=0,sl_cur=0,sl_next=SLOTB;
  #define ROT() do{sl_prev=sl_cur;sl_cur=sl_next;sl_next=(sl_next==(NSLOT-1)*SLOTB)?0:sl_next+SLOTB;}while(0)
  DMA_K(2,2*SLOTB);
  WAIT_BAR(3);
  qkt(pA0,pA1,Kbase,qr,negm,r32,hi);asm volatile("s_nop 15\n\ts_nop 7":"+v"(pA0),"+v"(pA1));CMASK(pA0,pA1,0);
  START(pA0,pA1);
  _Pragma("unroll") for(int r=0;r<16;++r)pA1[r]=__builtin_amdgcn_exp2f(pA1[r]);
  WAIT_BAR(0);
  DMA_K(3,0);DMA_V(1,SLOTB);
  ROT();
  kload8(kf,kp0+sl_cur);
  WAIT_BAR(2);
  s16x4 vlo[8],vhi[8]; u32x4 pw0,pw1,pw2,pw3;
  #define PKW(P,B) cvtpk_s(P[B],P[B+1])
  #define PAF(k) __builtin_bit_cast(bf16x8,pw##k)
  #define VFR(i) (bf16x8){vlo[i][0],vlo[i][1],vlo[i][2],vlo[i][3],vhi[i][0],vhi[i][1],vhi[i][2],vhi[i][3]}
  #define PIN(x) asm volatile("":"+v"(x))
  #define MX3(a,b,c) __builtin_fmaxf(__builtin_fmaxf((a),(b)),(c))
  #define GAPA(MF,A0,A1,A2,A3,W0,W1,PW) do{ MF; sacc+=A0; sacc+=A1; sacc+=A2; sacc+=A3; PIN(sacc); W0; W1; PIN(PW); SBAR(); }while(0)
  #define EX(v) __builtin_amdgcn_exp2f(v)
  #define GAPB(MF,X,B) do{ MF; X[B]=EX(X[B]); X[B+1]=EX(X[B+1]); X[B+2]=EX(X[B+2]); X[B+3]=EX(X[B+3]); PIN(X); SBAR(); }while(0)
  #define VRD(i) do{ vlo[i]=vtr(vp_+(((i)>>2)*4096+((i)&3)*1024)); vhi[i]=vtr(vp_+(((i)>>2)*4096+((i)&3)*1024+512)); }while(0)
  #define KRD(G,j) do{ if(G){ kload2(kf,kp0+sl_next,j); SBAR(); } }while(0)
  #define STEP(C0,C1,P0,P1,t,GK,GV,GL) do{ SBAR(); \
    const lds_cptr vp_=vp0+sl_prev; \
    VRD(0); SBAR(); float sacc=(P0[0]+P0[1]); \
    GAPA(C0=__builtin_amdgcn_mfma_f32_32x32x16_bf16(kf[0],qr[0],negm,0,0,0), P0[2],P0[3],P0[4],P0[5],     pw0[0]=PKW(P0,0), pw0[1]=PKW(P0,2), pw0); \
    VRD(4); SBAR(); GAPA(C1=__builtin_amdgcn_mfma_f32_32x32x16_bf16(kf[1],qr[0],negm,0,0,0), P0[6],P0[7],P0[8],P0[9],     pw0[2]=PKW(P0,4), pw0[3]=PKW(P0,6), pw0); \
    VRD(1); SBAR(); GAPA(C0=__builtin_amdgcn_mfma_f32_32x32x16_bf16(kf[2],qr[1],C0,0,0,0),   P0[10],P0[11],P0[12],P0[13], pw1[0]=PKW(P0,8), pw1[1]=PKW(P0,10), pw1); \
    VRD(5); SBAR(); GAPA(C1=__builtin_amdgcn_mfma_f32_32x32x16_bf16(kf[3],qr[1],C1,0,0,0),   P0[14],P0[15],P1[0],P1[1],   pw1[2]=PKW(P0,12),pw1[3]=PKW(P0,14), pw1); \
    VRD(2); SBAR(); GAPA(C0=__builtin_amdgcn_mfma_f32_32x32x16_bf16(kf[4],qr[2],C0,0,0,0),   P1[2],P1[3],P1[4],P1[5],     pw2[0]=PKW(P1,0), pw2[1]=PKW(P1,2), pw2); \
    VRD(6); SBAR(); GAPA(C1=__builtin_amdgcn_mfma_f32_32x32x16_bf16(kf[5],qr[2],C1,0,0,0),   P1[6],P1[7],P1[8],P1[9],     pw2[2]=PKW(P1,4), pw2[3]=PKW(P1,6), pw2); \
    VRD(3); SBAR(); GAPA(C0=__builtin_amdgcn_mfma_f32_32x32x16_bf16(kf[6],qr[3],C0,0,0,0),   P1[10],P1[11],P1[12],P1[13], pw3[0]=PKW(P1,8), pw3[1]=PKW(P1,10), pw3); \
    VRD(7); SBAR(); GAPA(C1=__builtin_amdgcn_mfma_f32_32x32x16_bf16(kf[7],qr[3],C1,0,0,0),   P1[14],P1[15],0.f,0.f,       pw3[2]=PKW(P1,12),pw3[3]=PKW(P1,14), pw3); \
    l_reg+=sacc; \
    if(GK){DMA_K((t)+3,sl_cur);} if(GV){DMA_V((t)+1,sl_next);} \
    CMASK(C0,C1,t); \
    { float a=MX3(C0[0],C0[1],C1[0]),b=MX3(C0[2],C0[3],C1[1]); a=MX3(a,C1[2],C1[3]); \
      _Pragma("unroll") for(int r=4;r<16;r+=4){a=MX3(a,C0[r],C0[r+1]);b=MX3(b,C0[r+2],C0[r+3]);a=MX3(a,C1[r],C1[r+1]);b=MX3(b,C1[r+2],C1[r+3]);} \
      float rm=__builtin_fmaxf(a,b); { auto rr=__builtin_amdgcn_permlane32_swap(__float_as_uint(rm),__float_as_uint(rm),false,false); rm=__builtin_fmaxf(__uint_as_float(rr[0]),__uint_as_float(rr[1])); } \
      resc=false; \
      if(__builtin_expect(__any(rm>(float)THRL),0)){ const float dl=__builtin_fmaxf(rm,0.f); mhat+=dl; \
        _Pragma("unroll") for(int r=0;r<16;++r){C0[r]-=dl;C1[r]-=dl;} \
        _Pragma("unroll") for(int r=0;r<16;++r)negm[r]=-mhat; asm volatile("":"+v"(negm)); \
        const float f=__builtin_amdgcn_exp2f(-dl); l_reg*=f; if(hi==0)wsf[r32]=f; resc=true; } } \
    SBAR(); \
    GAPB(o[0]=__builtin_amdgcn_mfma_f32_32x32x16_bf16(PAF(0),VFR(0),o[0],0,0,0), C0,0); \
    GAPB(o[1]=__builtin_amdgcn_mfma_f32_32x32x16_bf16(PAF(0),VFR(4),o[1],0,0,0), C0,4); \
    KRD(GL,0); GAPB(o[0]=__builtin_amdgcn_mfma_f32_32x32x16_bf16(PAF(1),VFR(1),o[0],0,0,0), C0,8); \
    KRD(GL,1); GAPB(o[1]=__builtin_amdgcn_mfma_f32_32x32x16_bf16(PAF(1),VFR(5),o[1],0,0,0), C0,12); \
    KRD(GL,2); GAPB(o[0]=__builtin_amdgcn_mfma_f32_32x32x16_bf16(PAF(2),VFR(2),o[0],0,0,0), C1,0); \
    KRD(GL,3); GAPB(o[1]=__builtin_amdgcn_mfma_f32_32x32x16_bf16(PAF(2),VFR(6),o[1],0,0,0), C1,4); \
    GAPB(o[0]=__builtin_amdgcn_mfma_f32_32x32x16_bf16(PAF(3),VFR(3),o[0],0,0,0), C1,8); \
    GAPB(o[1]=__builtin_amdgcn_mfma_f32_32x32x16_bf16(PAF(3),VFR(7),o[1],0,0,0), C1,12); \
    }while(0)
  int t=1;
  for(;t+5<NT;t+=2){
    STEP(pB0,pB1,pA0,pA1,t,true,true,true);     WAIT_BAR(2); RESC(); ROT();
    STEP(pA0,pA1,pB0,pB1,t+1,true,true,true);   WAIT_BAR(2); RESC(); ROT();
  }
  #define ENDW(tt) do{ if((tt)+3<NT){WAIT_BAR(2);} else if((tt)+2<NT){WAIT_BAR(1);} else {WAIT_BAR(0);} }while(0)
  for(;t+1<NT;t+=2){
    STEP(pB0,pB1,pA0,pA1,t,(t+3<NT),(t+1<NT),(t+1<NT));       ENDW(t);   RESC(); ROT();
    STEP(pA0,pA1,pB0,pB1,t+1,(t+4<NT),(t+2<NT),(t+2<NT));     ENDW(t+1); RESC(); ROT();
  }
  STEP(pB0,pB1,pA0,pA1,NT-1,false,false,false); RESC();
  { float sacc=pB0[0]+pB0[1]; _Pragma("unroll") for(int r=2;r<16;++r)sacc+=pB0[r]; _Pragma("unroll") for(int r=0;r<16;++r)sacc+=pB1[r]; l_reg+=sacc;
    pw0=(u32x4){PKW(pB0,0),PKW(pB0,2),PKW(pB0,4),PKW(pB0,6)};pw1=(u32x4){PKW(pB0,8),PKW(pB0,10),PKW(pB0,12),PKW(pB0,14)};pw2=(u32x4){PKW(pB1,0),PKW(pB1,2),PKW(pB1,4),PKW(pB1,6)};pw3=(u32x4){PKW(pB1,8),PKW(pB1,10),PKW(pB1,12),PKW(pB1,14)};
    SBAR(); pv(o,vb0+sl_cur,PAF(0),PAF(1),PAF(2),PAF(3)); }
  #undef PKW
  #undef PAF
  #undef VFR
  #undef PIN
  #undef MX3
  #undef GAPA
  #undef GAPB
  #undef EX
  #undef VRD
  #undef KRD
  #undef STEP
  #undef ENDW
  {auto rr=__builtin_amdgcn_permlane32_swap(__float_as_uint(l_reg),__float_as_uint(l_reg),false,false);l_reg=__uint_as_float(rr[0])+__uint_as_float(rr[1]);}
  if(has_sink)l_reg+=__builtin_amdgcn_exp2f(sinkl-mhat);
  if(hi==0)wsf[32+r32]=l_reg;asm volatile("s_waitcnt lgkmcnt(0)":::"memory");
  float rli[16];
  #pragma unroll
  for(int r=0;r<16;++r)rli[r]=__builtin_amdgcn_rcpf(wsf[32+crow(r,hi)]);
  bf16*Ow=Orow0+(long)(wid*QBLK)*OP;
  { bf16*stg=(bf16*)(shm+LDS_OST)+wid*2048;
    #pragma unroll
    for(int r=0;r<16;++r){const int orow=crow(r,hi);
      #pragma unroll
      for(int d0=0;d0<2;++d0)stg[orow*64+d0*32+r32]=(bf16)(cvtpk_s(o[d0][r]*rli[r],0.f)&0xffffu);}
    asm volatile("s_waitcnt lgkmcnt(0)":::"memory");
    #pragma unroll
    for(int i=0;i<4;++i){const int row=i*8+(lane>>3),ch=lane&7; const u32x4 v=*(const u32x4*)(stg+row*64+ch*8); ATTN_STORE16(Ow+(long)row*OP+ch*8,v);} }
  asm volatile("s_waitcnt lgkmcnt(0)\n\ts_barrier":::"memory");
  #undef DMA_K
  #undef KROW
  #undef DMA_V
  #undef CMASK
  #undef START
  #undef RESC
  #undef ROT
}
constexpr int ATTN_LDS_BYTES=LDS_BYTES;
#undef SBAR
#undef WAIT_BAR
}

constexpr int CW_Q = 32768;
__device__ __forceinline__ void attn_item(Ctx& c, int l, int it, int g) {
    const bf16* P = c_P; bf16* MIX = c_ACT; char* shm = (char*)c.lds;
    int b, hq, pc, ocol, NTl, woff = 0, kq0 = 0; size_t qrow; bool sink = false, domask = false;
    if (it < 2) { b = g >> 5; hq = (g >> 3) & 3; const int qb = g & 7; qrow = (size_t)b * TPB + CTXL + qb * 256; pc = it ? PC_C : PC_B; ocol = 512 + it * 256 + hq * 64;
        if (it == 0) NTl = 36;
        else { const int w0 = 4 * qb - 2 > 0 ? 4 * qb - 2 : 0, we = 4 * qb + 5 < 31 ? 4 * qb + 5 : 31; NTl = 4 + we - w0 + 1; woff = w0 * 64; kq0 = (w0 - 4) * 64 - qb * 256; sink = true; domask = true; } }
    else { const int typ = g >> 5; b = (g >> 2) & 7; hq = g & 3; qrow = (size_t)b * TPB; pc = typ ? PC_C : PC_B; ocol = 512 + typ * 256 + hq * 64; NTl = 4; sink = typ == 1; }
    const float sinkl = sink ? c_in(16)[l * 4 + hq] * LOG2E : 0.f;
    const bf16* Kh = P + (size_t)b * TPB * NP + pc + 256 + (hq >> 1) * 64;
    attn_body::attn_unit<8>(P + qrow * NP + pc + hq * 64, Kh, Kh + 128, MIX + qrow * DM + ocol, NTl, woff, kq0, sinkl, sink, domask, shm, c.tid);
}
namespace gdn {
typedef short s16x4 __attribute__((ext_vector_type(4)));
typedef float f32x2_t __attribute__((ext_vector_type(2))); typedef __bf16 bf16x2_t __attribute__((ext_vector_type(2)));
__device__ __forceinline__ unsigned cvtpk(float lo, float hi) { f32x2_t v = {lo, hi}; bf16x2_t b = __builtin_convertvector(v, bf16x2_t); return __builtin_bit_cast(unsigned, b); }
__device__ __forceinline__ s16x4 pack4(const f32x4& v) { unsigned a = cvtpk(v[0], v[1]), b = cvtpk(v[2], v[3]); typedef unsigned u32x2 __attribute__((ext_vector_type(2))); u32x2 u = {a, b}; return __builtin_bit_cast(s16x4, u); }
__device__ __forceinline__ bf16x8 cat44(s16x4 a, s16x4 b) { return (bf16x8){a[0], a[1], a[2], a[3], b[0], b[1], b[2], b[3]}; }
template <int CTRL> __device__ __forceinline__ float dpp(float x) { return __builtin_bit_cast(float, __builtin_amdgcn_mov_dpp(__builtin_bit_cast(int, x), CTRL, 0xf, 0xf, true)); }
__device__ __forceinline__ float xrow16_sum(float x) {
    auto s = __builtin_amdgcn_permlane16_swap(__float_as_uint(x), __float_as_uint(x), false, false);
    x = __uint_as_float(s[0]) + __uint_as_float(s[1]);
    auto t = __builtin_amdgcn_permlane32_swap(__float_as_uint(x), __float_as_uint(x), false, false);
    return __uint_as_float(t[0]) + __uint_as_float(t[1]);
}
__device__ __forceinline__ float wsum64(float x) {
    x += dpp<0xB1>(x); x += dpp<0x4E>(x); x += dpp<0x124>(x); x += dpp<0x128>(x); return xrow16_sum(x);
}
__device__ __forceinline__ float rdlane(float v, int idx) { return __builtin_bit_cast(float, __builtin_amdgcn_readlane(__builtin_bit_cast(int, v), idx)); }
#define GD_MFMA(a, b, c) __builtin_amdgcn_mfma_f32_16x16x32_bf16((a), (b), (c), 0, 0, 0)
#define GD_BAR() asm volatile("s_waitcnt lgkmcnt(0)\n\ts_barrier" ::: "memory")
constexpr int RP = 72, TP = 68;
constexpr int LQS = 0, LKS = 9216, LRT = 18432, LLM = 53248, LAM = 62464, LQD = 71680, LKET = 80896, LWL = 90112, LSTT = 99328, LDG = 108544, LDI = 112640, DIP = 24,
              LGC = 115712, LBETA = 115968, LSC = 116224, LQD2 = 116480, LKET2 = 125696, LDS_END = 134912;
#define GD_BF(off) ((LAS bf16*)(lds + (off)))
#define GD_F(off)  ((LAS float*)(lds + (off)))

__device__ __forceinline__ void gdn_fast_unit(const Ctx& c, int l, int u) {
    LAS unsigned char* lds = c.lds;
    const int d = u & 1, h = (u >> 1) & 7, b = u >> 4, lane0 = c.lane, w = c.wave;
#define GD_LANE() int lane = lane0; float zf_ = 0.f; asm volatile("" : "+v"(lane), "+v"(zf_)); const int g4 = lane >> 4, l15 = lane & 15; (void)g4; (void)l15; (void)zf_
#define GD_Z4 ((f32x4){zf_, zf_, zf_, zf_})
    const bf16* Qn = (const bf16*)c_OG; const float* Gt = c_Gt; bf16* og = c_P + d * 512;
    const float Aexp = __expf(c_in(9)[l * 16 + d * 8 + h]), dtb = c_in(10)[l * 16 + d * 8 + h];
    f32x4 Sacc[4];
    { float zf_ = 0.f; asm volatile("" : "+v"(zf_));
#pragma unroll
    for (int rt = 0; rt < 4; ++rt) Sacc[rt] = GD_Z4; }
    for (int i = c.tid; i < 64 * RP / 2; i += NTHREADS) ((LAS unsigned*)(lds + LSTT))[i] = 0u;
#define GD_GEOM(cc_) const int seg = (cc_) >= 4, len = seg ? SEQ : CTXL, base = b * TPB + (seg ? CTXL : 0), ci = seg ? (cc_) - 4 : (cc_), c0 = d ? len - 64 - 64 * ci : 64 * ci; (void)len
#define GD_LOAD(cc_) do { GD_GEOM(cc_); GD_LANE(); const int tb = d ? c0 + 48 - 16 * (w - 4) : c0 + 16 * (w - 4); \
        _Pragma("unroll") for (int m = 0; m < 16; ++m) { const bf16* pr = Qn + (size_t)(base + tb + m) * 1536 + h * 64 + lane; rq[m] = pr[0]; rk[m] = pr[512]; rv[m] = pr[1024]; } \
        { const int R = base + (d ? c0 + 63 - lane : c0 + lane); rbraw = Gt[(size_t)R * 32 + d * 8 + h]; raraw = Gt[(size_t)R * 32 + 16 + d * 8 + h]; } } while (0)
#define GD_STEP_A(cc_) do { GD_LANE(); const int wl = w - 4, set = (cc_) & 1; \
        _Pragma("unroll") for (int m = 0; m < 16; ++m) asm volatile("" : "+v"(rq[m]), "+v"(rk[m]), "+v"(rv[m])); \
        asm volatile("" : "+v"(rbraw), "+v"(raraw)); \
        const float beta = 1.f / (1.f + __expf(-rbraw)); \
        const float ar = raraw + dtb; const float sp = ar > 20.f ? ar : __logf(1.f + __expf(ar)); \
        float gc = -Aexp * sp; \
        gc += dpp<0x111>(gc); gc += dpp<0x112>(gc); gc += dpp<0x114>(gc); gc += dpp<0x118>(gc); \
        { const float t15 = rdlane(gc, 15), t31 = rdlane(gc, 31), t47 = rdlane(gc, 47); gc += (g4 >= 1 ? t15 : 0.f) + (g4 >= 2 ? t31 : 0.f) + (g4 >= 3 ? t47 : 0.f); } \
        const float gl = rdlane(gc, 63); \
        const float egc = __expf(gc), ekl = __expf(gl - gc), bge = beta * egc; \
        if (wl == 0) { GD_F(LGC)[lane] = gc; GD_F(LBETA)[lane] = beta; if (lane == 0) GD_F(LSC)[set] = __expf(gl); } \
        float ket[16], kg[16], vb[16]; \
        LAS bf16* QDs = GD_BF(set ? LQD2 : LQD); LAS bf16* KETs = GD_BF(set ? LKET2 : LKET); \
        _Pragma("unroll") for (int i = 0; i < 16; ++i) { const int r = d ? 16 * wl + 15 - i : 16 * wl + i; \
            const float q = __builtin_bit_cast(float, rq[i] << 16), k = __builtin_bit_cast(float, rk[i] << 16), v = __builtin_bit_cast(float, rv[i] << 16); \
            GD_BF(LQS)[r * RP + lane] = (bf16)rq[i]; GD_BF(LKS)[r * RP + lane] = (bf16)rk[i]; QDs[r * RP + lane] = (bf16)(cvtpk(q * rdlane(egc, r), 0.f) & 0xffffu); \
            ket[i] = k * rdlane(ekl, r); kg[i] = k * rdlane(bge, r); vb[i] = v * rdlane(beta, r); } \
          \
        _Pragma("unroll") for (int q4 = 0; q4 < 4; ++q4) { f32x4 kv, vv; \
            _Pragma("unroll") for (int e = 0; e < 4; ++e) { kv[e] = d ? kg[15 - 4 * q4 - e] : kg[4 * q4 + e]; vv[e] = d ? vb[15 - 4 * q4 - e] : vb[4 * q4 + e]; } \
            *(LAS f32x4*)(GD_F(LRT) + lane * TP + 16 * wl + 4 * q4) = vv; *(LAS f32x4*)(GD_F(LRT) + (64 + lane) * TP + 16 * wl + 4 * q4) = kv; } \
        _Pragma("unroll") for (int q8 = 0; q8 < 2; ++q8) { unsigned kp[4]; \
            _Pragma("unroll") for (int e = 0; e < 4; ++e) { const float a = d ? ket[15 - 8 * q8 - 2 * e] : ket[8 * q8 + 2 * e], bq = d ? ket[14 - 8 * q8 - 2 * e] : ket[8 * q8 + 2 * e + 1]; kp[e] = cvtpk(a, bq); } \
            *(LAS v4u*)(KETs + lane * RP + 16 * wl + 8 * q8) = (v4u){kp[0], kp[1], kp[2], kp[3]}; } } while (0)
    unsigned rq[16], rk[16], rv[16]; float rbraw = 0.f, raraw = 0.f;
    if (w >= 4) { GD_LOAD(0); GD_STEP_A(0); GD_LOAD(1); }
    GD_BAR();
    for (int cc = 0; cc < 36; ++cc) {
        GD_GEOM(cc);
        const bool store_o = !(seg == 0 && l == NL - 1);
        const int set = cc & 1;
        f32x4 X[4];
        for (int repB_ = 0; repB_ < (DUP == 36 ? 2 : 1); ++repB_) {
        for (int r37_ = 0; r37_ < (DUP == 37 ? 2 : 1); ++r37_) {
            GD_LANE();
            const int mat = w >> 2, ti = w & 3, i = 16 * ti + l15;
            LAS const bf16* Xs = mat ? GD_BF(LQS) : GD_BF(LKS);
            const bf16x8 x0 = *(LAS const bf16x8*)(Xs + i * RP + 8 * g4), x1 = *(LAS const bf16x8*)(Xs + i * RP + 32 + 8 * g4);
            const float gci = GD_F(LGC)[i], bti = mat ? 1.f : -GD_F(LBETA)[i];
            LAS bf16* Out = mat ? GD_BF(LAM) : GD_BF(LLM);
#pragma unroll
            for (int tj = 0; tj < 4; ++tj) {
                f32x4 o4 = GD_Z4;
                if (tj <= ti) {
                    const bf16x8 k0 = *(LAS const bf16x8*)(GD_BF(LKS) + (16 * tj + l15) * RP + 8 * g4), k1 = *(LAS const bf16x8*)(GD_BF(LKS) + (16 * tj + l15) * RP + 32 + 8 * g4);
                    const f32x4 gcj = *(LAS const f32x4*)(GD_F(LGC) + 16 * tj + 4 * g4);
                    f32x4 acc = GD_MFMA(k0, x0, GD_Z4); acc = GD_MFMA(k1, x1, acc);
#pragma unroll
                    for (int r = 0; r < 4; ++r) { const int j = 16 * tj + 4 * g4 + r; const float dec = __expf(fminf(gci - gcj[r], 0.f));
                        const bool keep = mat ? (i >= j) : (i > j); o4[r] = keep ? bti * acc[r] * dec : 0.f; }
                    if (tj == ti && mat == 0) {
#pragma unroll
                        for (int r = 0; r < 4; ++r) GD_F(LDG)[(ti * 16 + 4 * g4 + r) * 16 + l15] = -o4[r]; }
                }
                *(LAS s16x4*)(Out + i * RP + 16 * tj + 4 * g4) = pack4(o4);
            }
        }
        GD_BAR();
        if (w == 0) for (int r38_ = 0; r38_ < (DUP == 38 ? 2 : 1); ++r38_) {
            GD_LANE();
            const int bb = lane >> 4, cc2 = lane & 15; LAS const float* NTr = GD_F(LDG) + bb * 256;
            float x[16];
#pragma unroll
            for (int i = 0; i < 16; ++i) x[i] = (i == cc2) ? 1.f : 0.f;
#pragma unroll
            for (int j = 0; j < 15; ++j) {
                f32x4 n[4];
#pragma unroll
                for (int q = (j + 1) >> 2; q < 4; ++q) n[q] = *(LAS const f32x4*)(NTr + j * 16 + 4 * q);
#pragma unroll
                for (int i = j + 1; i < 16; ++i) x[i] -= n[i >> 2][i & 3] * x[j];
            }
#pragma unroll
            for (int i = 0; i < 16; ++i) GD_BF(LDI)[(bb * 16 + i) * DIP + cc2] = (bf16)(cvtpk(x[i], 0.f) & 0xffffu);
        }
        GD_BAR();
        for (int r39_ = 0; r39_ < (DUP == 39 ? 2 : 1); ++r39_) {
            GD_LANE();
            s16x4 Xp[4]; const s16x4 z4 = (s16x4){0, 0, 0, 0};
            f32x4 Yin[4]; s16x4 la1, la2, lb2, la3, lb3, lc3, di[4];
#pragma unroll
            for (int bb = 0; bb < 4; ++bb) { Yin[bb] = *(LAS const f32x4*)(GD_F(LRT) + (16 * w + l15) * TP + 16 * bb + 4 * g4); di[bb] = *(LAS const s16x4*)(GD_BF(LDI) + (bb * 16 + l15) * DIP + 4 * g4); }
            { LAS const bf16* lr = GD_BF(LLM) + l15 * RP + 4 * g4; la1 = *(LAS const s16x4*)(lr + 16 * RP); la2 = *(LAS const s16x4*)(lr + 32 * RP); lb2 = *(LAS const s16x4*)(lr + 32 * RP + 16);
              la3 = *(LAS const s16x4*)(lr + 48 * RP); lb3 = *(LAS const s16x4*)(lr + 48 * RP + 16); lc3 = *(LAS const s16x4*)(lr + 48 * RP + 32); }
            const f32x4 zero4 = GD_Z4;
            X[0] = GD_MFMA(cat44(di[0], z4), cat44(pack4(Yin[0]), z4), zero4); Xp[0] = pack4(X[0]);
            f32x4 Y = GD_MFMA(cat44(la1, z4), cat44(Xp[0], z4), Yin[1]);
            X[1] = GD_MFMA(cat44(di[1], z4), cat44(pack4(Y), z4), zero4); Xp[1] = pack4(X[1]);
            Y = GD_MFMA(cat44(la2, lb2), cat44(Xp[0], Xp[1]), Yin[2]);
            X[2] = GD_MFMA(cat44(di[2], z4), cat44(pack4(Y), z4), zero4); Xp[2] = pack4(X[2]);
            Y = GD_MFMA(cat44(la3, lb3), cat44(Xp[0], Xp[1]), Yin[3]); Y = GD_MFMA(cat44(lc3, z4), cat44(Xp[2], z4), Y);
            X[3] = GD_MFMA(cat44(di[3], z4), cat44(pack4(Y), z4), zero4);
            if (w >= 4) {
#pragma unroll
                for (int bb = 0; bb < 4; ++bb)
#pragma unroll
                    for (int r = 0; r < 4; ++r) GD_BF(LWL)[(16 * bb + 4 * g4 + r) * RP + 16 * (w - 4) + l15] = (bf16)(cvtpk(-X[bb][r], 0.f) & 0xffffu);
            }
        }
        GD_BAR();
        }
        if (w < 4) { f32x4 Snew[4];
          for (int r40_ = 0; r40_ < (DUP == 40 ? 2 : 1); ++r40_) {
            GD_LANE();
            LAS const bf16* QDs = GD_BF(set ? LQD2 : LQD); LAS const bf16* KETs = GD_BF(set ? LKET2 : LKET);
            const bf16x8 sb0 = *(LAS const bf16x8*)(GD_BF(LSTT) + (16 * w + l15) * RP + 8 * g4), sb1 = *(LAS const bf16x8*)(GD_BF(LSTT) + (16 * w + l15) * RP + 32 + 8 * g4);
            f32x4 Vn[4], O[4];
#pragma unroll
            for (int hp = 0; hp < 2; ++hp) { bf16x8 wf[2][2], qf[2][2];
#pragma unroll
                for (int q = 0; q < 2; ++q) { const int rt = 2 * hp + q; LAS const bf16* wr = GD_BF(LWL) + (16 * rt + l15) * RP + 8 * g4; LAS const bf16* qr = QDs + (16 * rt + l15) * RP + 8 * g4;
                    wf[q][0] = *(LAS const bf16x8*)(wr); wf[q][1] = *(LAS const bf16x8*)(wr + 32); qf[q][0] = *(LAS const bf16x8*)(qr); qf[q][1] = *(LAS const bf16x8*)(qr + 32); }
#pragma unroll
                for (int q = 0; q < 2; ++q) { const int rt = 2 * hp + q; Vn[rt] = GD_MFMA(wf[q][0], sb0, X[rt]); Vn[rt] = GD_MFMA(wf[q][1], sb1, Vn[rt]);
                    O[rt] = GD_MFMA(qf[q][0], sb0, GD_Z4); O[rt] = GD_MFMA(qf[q][1], sb1, O[rt]); } }
            const bf16x8 vp0 = cat44(pack4(Vn[0]), pack4(Vn[1])), vp1 = cat44(pack4(Vn[2]), pack4(Vn[3]));
            const float egl = GD_F(LSC)[set];
#pragma unroll
            for (int hp = 0; hp < 2; ++hp) { bf16x8 af[2][2], kf[2][2];
#pragma unroll
                for (int q = 0; q < 2; ++q) { const int rt = 2 * hp + q; LAS const bf16* ar = GD_BF(LAM) + (16 * rt + l15) * RP + 4 * g4; LAS const bf16* kr = KETs + (16 * rt + l15) * RP + 4 * g4;
                    af[q][0] = cat44(*(LAS const s16x4*)(ar), *(LAS const s16x4*)(ar + 16)); af[q][1] = cat44(*(LAS const s16x4*)(ar + 32), *(LAS const s16x4*)(ar + 48));
                    kf[q][0] = cat44(*(LAS const s16x4*)(kr), *(LAS const s16x4*)(kr + 16)); kf[q][1] = cat44(*(LAS const s16x4*)(kr + 32), *(LAS const s16x4*)(kr + 48)); }
#pragma unroll
                for (int q = 0; q < 2; ++q) { const int rt = 2 * hp + q; O[rt] = GD_MFMA(af[q][0], vp0, O[rt]); O[rt] = GD_MFMA(af[q][1], vp1, O[rt]);
                    f32x4 S2 = Sacc[rt] * egl; S2 = GD_MFMA(kf[q][0], vp0, S2); S2 = GD_MFMA(kf[q][1], vp1, S2); Snew[rt] = S2; } }
            if (store_o) {
#pragma unroll
                for (int rt = 0; rt < 4; ++rt)
#pragma unroll
                    for (int r = 0; r < 4; ++r) { const int i = 16 * rt + 4 * g4 + r; const int R = base + (d ? c0 + 63 - i : c0 + i); og[(size_t)R * NP + h * 64 + 16 * w + l15] = (bf16)(cvtpk(O[rt][r], 0.f) & 0xffffu); }
            }
          }
          { GD_LANE();
#pragma unroll
          for (int rt = 0; rt < 4; ++rt) { Sacc[rt] = Snew[rt]; *(LAS s16x4*)(GD_BF(LSTT) + (16 * w + l15) * RP + 16 * rt + 4 * g4) = pack4(Snew[rt]); } }
        } else if (cc + 1 < 36) {
            for (int repA_ = 0; repA_ < (DUP == 35 ? 2 : 1); ++repA_) GD_STEP_A(cc + 1);
            if (cc + 2 < 36) GD_LOAD(cc + 2);
        }
        GD_BAR();
    }
#undef GD_GEOM
#undef GD_LOAD
#undef GD_STEP_A
#undef GD_LANE
#undef GD_Z4
}
#undef GD_BF
#undef GD_F
}

__device__ __forceinline__ void gdn_qkv_phase(Ctx& c, int l) {
    const bf16* P = c_P; bf16* Qn = (bf16*)c_OG; const int lane = c.lane;
    const float* cw = c_in(8) + (size_t)l * 5 * 1536;
    for (int it = c.gw; it < (NT / 8) * GH; it += c.NGW) {
        const int h = it & 7, blk = it >> 3, R0 = blk * 8; const int b = R0 / TPB, tp0 = R0 - b * TPB; const bool isctx = tp0 < CTXL;
        const int len = isctx ? CTXL : SEQ, base = b * TPB + (isctx ? 0 : CTXL), tb = tp0 - (isctx ? 0 : CTXL);
        unsigned rq[12], rk[12], rv[12];
#pragma unroll
        for (int m = 0; m < 12; ++m) { int tok = tb - 2 + m; tok = tok < 0 ? 0 : (tok >= len ? len - 1 : tok); const bf16* pr = P + (size_t)(base + tok) * NP + h * 64 + lane; rq[m] = pr[0]; rk[m] = pr[512]; rv[m] = pr[1024]; }
        float wq[5], wk[5], wv[5];
#pragma unroll
        for (int j = 0; j < 5; ++j) { wq[j] = cw[j * 1536 + h * 64 + lane]; wk[j] = cw[j * 1536 + 512 + h * 64 + lane]; wv[j] = cw[j * 1536 + 1024 + h * 64 + lane]; }
        float xq[12], xk[12], xv[12];
#pragma unroll
        for (int m = 0; m < 12; ++m) { const int tok = tb - 2 + m; const float vm = (tok >= 0 && tok < len) ? 1.f : 0.f;
            xq[m] = __builtin_bit_cast(float, rq[m] << 16) * vm; xk[m] = __builtin_bit_cast(float, rk[m] << 16) * vm; xv[m] = __builtin_bit_cast(float, rv[m] << 16) * vm; }
#pragma unroll
        for (int i = 0; i < 8; ++i) { float aq = 0.f, ak = 0.f, av = 0.f;
#pragma unroll
            for (int j = 0; j < 5; ++j) { aq += wq[j] * xq[i + j]; ak += wk[j] * xk[i + j]; av += wv[j] * xv[i + j]; }
            const float yq = aq * __builtin_amdgcn_rcpf(1.f + __expf(-aq)), yk = ak * __builtin_amdgcn_rcpf(1.f + __expf(-ak)), yv = av * __builtin_amdgcn_rcpf(1.f + __expf(-av));
            const float sq = gdn::wsum64(yq * yq), sk = gdn::wsum64(yk * yk);
            bf16* o = Qn + (size_t)(R0 + i) * 1536 + h * 64 + lane;
            const unsigned pq = gdn::cvtpk(yq * rsqrtf(sq + 1e-6f) * 0.125f, yk * rsqrtf(sk + 1e-6f)), pv = gdn::cvtpk(yv, 0.f);
            o[0] = (bf16)(pq & 0xffffu); o[512] = (bf16)(pq >> 16); o[1024] = (bf16)(pv & 0xffffu); }
    }
}

__device__ __forceinline__ void mixer_phase(Ctx& c, int l, int rep = 0) {
    unsigned* ctr = (unsigned*)(c.A->ws + WS_CTL) + CW_Q + 128 * l + 64 * rep;
    volatile LAS unsigned* slot = (volatile LAS unsigned*)(c.lds + MISC_OFF) + 16;
    const int nitems = (128 + 512 + (l == 0 ? 64 : 0)) * (DUP == 33 ? 2 : 1);
    for (;;) {
        if (c.tid == 0) slot[0] = __hip_atomic_fetch_add(ctr, 1u, __ATOMIC_RELAXED, __HIP_MEMORY_SCOPE_AGENT);
        __syncthreads();
        int item = __builtin_amdgcn_readfirstlane((int)slot[0]);
        __syncthreads();
        if (item >= nitems) break;
        if (DUP == 33) item >>= 1;
        Ctx ci = c;
        { int w_ = c.wave; asm volatile("" : "+s"(w_)); int l_; asm volatile("v_mbcnt_lo_u32_b32 %0, -1, 0\n\tv_mbcnt_hi_u32_b32 %0, -1, %0" : "=v"(l_)); ci.wave = w_; ci.lane = l_; ci.tid = w_ * 64 + l_; }
        if (item < 128) gdn::gdn_fast_unit(ci, l, item);
        else { const int a = item - 128; attn_item(ci, l, a < 256 ? 0 : (a < 512 ? 1 : 2), a & 255); }
    }
}

__device__ __forceinline__ void gdn_combine_phase(Ctx& c, int l) {
    const float* gn = c_in(11) + l * 64; const bf16* P = c_P; bf16* MIX = c_ACT; const int lane = c.lane;
    const f32x4 g0 = *(const f32x4*)(gn + 8 * (lane & 7)), g1 = *(const f32x4*)(gn + 8 * (lane & 7) + 4);
    for (int R = c.gw; R < NT; R += c.NGW) {
        if (l == NL - 1 && (R % TPB) < CTXL) continue;
        const bf16x8 of = *(const bf16x8*)(P + (size_t)R * NP + 8 * lane), ob = *(const bf16x8*)(P + (size_t)R * NP + 512 + 8 * lane);
        const bf16x8 zr = *(const bf16x8*)(P + (size_t)R * NP + PC_Z + 8 * lane);
        f32x4 v0, v1;
#pragma unroll
        for (int e = 0; e < 4; ++e) { v0[e] = bfs2f(of[e]) + bfs2f(ob[e]); v1[e] = bfs2f(of[4 + e]) + bfs2f(ob[4 + e]); }
        float ss = (v0[0] * v0[0] + v0[1] * v0[1]) + (v0[2] * v0[2] + v0[3] * v0[3]) + (v1[0] * v1[0] + v1[1] * v1[1]) + (v1[2] * v1[2] + v1[3] * v1[3]);
        ss += lane_xor(ss, 1, lane); ss += lane_xor(ss, 2, lane); ss += lane_xor(ss, 4, lane);
        const float rstd = rsqrtf(ss * (1.f / 64.f) + RMS_EPS);
        float y[8];
#pragma unroll
        for (int e = 0; e < 8; ++e) y[e] = (e < 4 ? v0[e] * g0[e] : v1[e - 4] * g1[e - 4]) * rstd * siluf(bfs2f(zr[e]));
        v4u o; o.x = pk2(y[0], y[1]); o.y = pk2(y[2], y[3]); o.z = pk2(y[4], y[5]); o.w = pk2(y[6], y[7]);
        *(v4u*)(MIX + (size_t)R * DM + 8 * lane) = o;
    }
}

__global__ void __launch_bounds__(NTHREADS, 2) mk_fwd(Args args) {
    extern __shared__ __attribute__((aligned(16))) unsigned char lds_raw[];
    typedef const __attribute__((address_space(4))) Args* KArgs;
    int wave_sgpr, lo, hi; unsigned char* ws;
    XcdBarrier bar;
    {
        const int tid0 = threadIdx.x; wave_sgpr = __builtin_amdgcn_readfirstlane(tid0 >> 6);
        KArgs A0 = (KArgs)__builtin_amdgcn_kernarg_segment_ptr();
        ws = A0->ws; lo = A0->ph_lo; hi = A0->ph_hi;
        LAS unsigned char* l0 = (LAS unsigned char*)lds_raw;
        for (int u = tid0; u < (LDS_BYTES - 131072) / 4; u += NTHREADS) ((LAS unsigned*)(l0 + 131072))[u] = 0u;
        __syncthreads();
        unsigned* barw = (unsigned*)(ws + WS_CTL) + CW_BAR + A0->li * XCD_BAR_WORDS;
        bar.bar = barw; bar.x = 0; bar.st = nullptr;
        if (hi - lo > 1) bar = xcd_barrier_post(barw, (volatile LAS unsigned*)(l0 + MISC_OFF) + 8, tid0 == 0);
    }
#ifndef ONLY
#define ONLY -1
#endif
#define EN(k) (ONLY < 0 || ONLY == (k))
#define PHASE(k, ...) do { const int k_ = (k); if (lo <= k_ && k_ < hi) { Ctx c; \
        { KArgs ap_ = (KArgs)__builtin_amdgcn_kernarg_segment_ptr(); asm volatile("" : "+s"(ap_)); c.A = ap_; } \
        { int w_ = wave_sgpr; asm volatile("" : "+s"(w_)); int l_; asm volatile("v_mbcnt_lo_u32_b32 %0, -1, 0\n\tv_mbcnt_hi_u32_b32 %0, -1, %0" : "=v"(l_)); \
          c.wave = w_; c.lane = l_; c.tid = w_ * 64 + l_; c.G = gridDim.x; c.bx = blockIdx.x; c.gw = c.bx * NWAVES + w_; c.NGW = c.G * NWAVES; c.lds = (LAS unsigned char*)lds_raw; } \
        { __VA_ARGS__ } if (DUP >= 0 && DUP != 5 && DUP != 8 && DUP != 2 && DUP != 3 && DUP == (k_ == 0 ? 10 : (k_ - 1) % 9)) { if (k_ > 0) __syncthreads(); __VA_ARGS__ } \
        if (k_ + 1 < hi) { xcd_barrier(bar, c.tid == 0); if (DUP == 20) xcd_barrier(bar, c.tid == 0); } } } while (0)
    PHASE(0, if (EN(10)) conv_weights(c, 0); __syncthreads(); if (EN(11)) ada_mod_phase(c););
#pragma unroll 1
    for (int l = 0; l < NL; ++l) {
        const int p0 = 1 + 9 * l; const bool last = (l == NL - 1);
        PHASE(p0 + 0, if (EN(0)) { if (l > 0) { conv_weights(c, l); __syncthreads(); } norm_phase(c, l, 0); });
        PHASE(p0 + 1, if (EN(1)) { pg8::Gemm g{c_ACT, c_Win_t, NT, NPG, DM, DM}; pg8::RowOrder S; S.init(NPG, c.G, c.bx, false); pg8::EpiInProjG E{c_P, c_Gt};
                  pg8::gemm_phase<pg8::EpiInProjG, pg8::RowOrder, true, true>(c.lds, g, S, E, c.tid); });
        PHASE(p0 + 2, if (EN(2)) { for (int rep_ = 0; rep_ < (DUP == 2 ? 2 : 1); ++rep_) attn_prep_phase(c, l, rep_ > 0); gdn_qkv_phase(c, l); });
        PHASE(p0 + 3, if (EN(3)) { for (int rep_ = 0; rep_ < (DUP == 3 ? 2 : 1); ++rep_) { if (rep_) xcd_barrier(bar, c.tid == 0); mixer_phase(c, l, rep_); __syncthreads(); } });
        PHASE(p0 + 4, if (EN(4)) gdn_combine_phase(c, l););
        PHASE(p0 + 5, if (EN(5)) { for (int rep_ = 0; rep_ < (DUP == 5 ? 2 : 1); ++rep_) { pg8::Gemm g{c_ACT, c_Wout_t, NT, DM, DM, DM}; pg8::RowOrder S; S.init(DM, c.G, c.bx, last);
                  pg8::EpiGateRes E{c_XSC, c_out, rep_ ? (const float*)(c.A->ws + WS_CTL + 512 * 1024) : c_MOD + (size_t)l * 9 * NMODC + 2 * DM};
                  pg8::gemm_phase<pg8::EpiGateRes, pg8::RowOrder, true, true>(c.lds, g, S, E, c.tid); } });
        PHASE(p0 + 6, if (EN(6)) norm_phase(c, l, 1););
        PHASE(p0 + 7, if (EN(7)) { pg8::Gemm g{c_ACT, c_W1_t, NT, DFF, DM, DM}; pg8::RowOrder S; S.init(DFF, c.G, c.bx, last); pg8::EpiBf16<2> E{c_H, DFF, nullptr, 0, 0, 1.f};
                  pg8::gemm_phase<pg8::EpiBf16<2>, pg8::RowOrder, true, true>(c.lds, g, S, E, c.tid); });
        PHASE(p0 + 8, if (EN(8)) { for (int rep_ = 0; rep_ < (DUP == 8 ? 2 : 1); ++rep_) {
                { pg8::Gemm g{c_H, c_W2_t, NT, DM, DFF, DFF}; pg8::RowOrder S; S.init(DM, c.G, c.bx, true);
                  pg8::EpiGateRes E{c_XSC, c_out, rep_ ? (const float*)(c.A->ws + WS_CTL + 512 * 1024) : c_MOD + (size_t)l * 9 * NMODC + 5 * DM};
                  pg8::gemm_phase<pg8::EpiGateRes, pg8::RowOrder, true, true>(c.lds, g, S, E, c.tid); }
                if (!last) { __syncthreads();
                  pg8::Gemm g{c_H, c_W2_t, NT, DM, DFF / 4, DFF}; pg8::CtxSplitOrder S; S.init(c.G, c.bx, 4, DFF); pg8::EpiSlab E{(float*)(c.A->ws + WS_SLAB), 4, DFF / 4};
                  pg8::gemm_phase<pg8::EpiSlab, pg8::CtxSplitOrder, true, true>(c.lds, g, S, E, c.tid); } } });
    }
}

#if !MIXER_IN_MAIN
__global__ void __launch_bounds__(NTHREADS, 2) mixer_k(Args args, int l) {
    extern __shared__ __attribute__((aligned(16))) unsigned char lds_raw2[];
    Ctx c; c.A = (const __attribute__((address_space(4))) Args*)__builtin_amdgcn_kernarg_segment_ptr();
    c.tid = threadIdx.x; c.lane = c.tid & 63; c.wave = __builtin_amdgcn_readfirstlane(c.tid >> 6); c.G = gridDim.x; c.bx = blockIdx.x; c.gw = c.bx * NWAVES + c.wave; c.NGW = c.G * NWAVES; c.lds = (LAS unsigned char*)lds_raw2;
    if (c.wave == 0 && c.bx < 128) gdn_naive_unit(c, l, c.bx, (LAS float*)c.lds);
}
#endif
extern "C" void kernel_launch(void* const* d_in, const int* in_sizes, int n_in, void* d_out, int out_size, void* d_ws, size_t ws_size, hipStream_t stream) {
    static int grid = 0;
    if (grid == 0) {
        if (n_in != 21 || out_size != NB * SEQ * DM || ws_size < WS_END) { fprintf(stderr, "kernel_launch: unexpected problem (n_in %d out %d ws %zu)\n", n_in, out_size, ws_size); grid = -1; return; }
        int dev = 0, cus = 0;
        if (hipGetDevice(&dev) != hipSuccess || hipDeviceGetAttribute(&cus, hipDeviceAttributeMultiprocessorCount, dev) != hipSuccess) { grid = -1; return; }
        if (hipFuncSetAttribute((const void*)mk_fwd, hipFuncAttributeMaxDynamicSharedMemorySize, LDS_BYTES) != hipSuccess) { fprintf(stderr, "kernel_launch: hipFuncSetAttribute failed\n"); grid = -1; return; }
        int per_cu = 0;
        if (hipOccupancyMaxActiveBlocksPerMultiprocessor(&per_cu, (const void*)mk_fwd, NTHREADS, LDS_BYTES) != hipSuccess || per_cu < 1) fprintf(stderr, "kernel_launch: occupancy query says %d\n", per_cu);
        (void)hipGetLastError();
        grid = cus;
    }
    if (grid < 0) return;
    if (hipMemsetAsync((char*)d_ws + WS_CTL, 0, CTL_ZERO_BYTES, stream) != hipSuccess) return;
    Args a{};
    for (int i = 0; i < 21; ++i) a.in[i] = (const float*)d_in[i];
    a.out = (float*)d_out; a.ws = (unsigned char*)d_ws;
#if MK_ONE_LAUNCH && MIXER_IN_MAIN
    a.ph_lo = 0; a.ph_hi = NPHASES; a.li = 0;
    hipLaunchKernelGGL(mk_fwd, dim3(grid), dim3(NTHREADS), LDS_BYTES, stream, a);
#elif MK_ONE_LAUNCH
    (void)hipFuncSetAttribute((const void*)mixer_k, hipFuncAttributeMaxDynamicSharedMemorySize, LDS_BYTES);
    for (int l = 0; l < NL; ++l) {
        a.ph_lo = l == 0 ? 0 : 1 + 9 * l - 6; a.ph_hi = 1 + 9 * l + 3; a.li = l;
        hipLaunchKernelGGL(mk_fwd, dim3(grid), dim3(NTHREADS), LDS_BYTES, stream, a);
        hipLaunchKernelGGL(mixer_k, dim3(grid), dim3(NTHREADS), LDS_BYTES, stream, a, l);
    }
    a.ph_lo = 1 + 9 * (NL - 1) + 3; a.ph_hi = NPHASES; a.li = NL;
    hipLaunchKernelGGL(mk_fwd, dim3(grid), dim3(NTHREADS), LDS_BYTES, stream, a);
#else
    for (int ph = 0; ph < NPHASES; ++ph) { a.ph_lo = ph; a.ph_hi = ph + 1; a.li = ph;
        hipLaunchKernelGGL(mk_fwd, dim3(grid), dim3(NTHREADS), LDS_BYTES, stream, a); }
#endif
}
```

```cpp
#include <hip/hip_runtime.h>
#include <cstdio>
#include <cstdint>

#define GAS __attribute__((address_space(1)))
#define LAS __attribute__((address_space(3)))
typedef unsigned short bf16;
typedef short bf16x8 __attribute__((ext_vector_type(8)));
typedef float f32x4 __attribute__((ext_vector_type(4)));
typedef float f32x2v __attribute__((ext_vector_type(2)));
typedef float f32x16 __attribute__((ext_vector_type(16)));
typedef unsigned v4u __attribute__((ext_vector_type(4)));
typedef GAS unsigned gu32;
#define RLX_AGENT __ATOMIC_RELAXED, __HIP_MEMORY_SCOPE_AGENT
#define LDS_WAIT() asm volatile("s_waitcnt lgkmcnt(0)" ::: "memory")

#ifndef MK_ONE_LAUNCH
#define MK_ONE_LAUNCH 1
#endif
#ifndef DUP
#define DUP -1
#endif
#ifndef MIXER_IN_MAIN
#define MIXER_IN_MAIN 1
#endif
constexpr int NWAVES = 8, NTHREADS = NWAVES * 64;

constexpr int DM = 1024, NB = 8, SEQ = 2048, CTXL = 256, TPB = SEQ + CTXL, NT = NB * TPB;
constexpr int NL = 2, DIN = 3104, NP = 3072, DFF = 4096, NMODC = 6 * DM;
constexpr int GH = 8;
constexpr float RMS_EPS = 1e-6f;
constexpr float C2 = 0.125f * 1.4426950408889634f;
constexpr float LOG2E = 1.4426950408889634f;
constexpr int PC_Z = 1536, PC_B = 2048, PC_C = 2560;
constexpr int NPHASES = 1 + 9 * NL;

constexpr size_t MiB = 1u << 20;
constexpr size_t WS_CTL = 0, CTL_ZERO_BYTES = 1 * MiB;
constexpr size_t WS_MOD = 1 * MiB;
constexpr size_t WS_ROPE = WS_MOD + 512 * 1024;
constexpr size_t WS_WIN = 2 * MiB;
constexpr int NPG = NP + 256;
constexpr size_t WS_WOUT = WS_WIN + (size_t)NPG * DM * 2;
constexpr size_t WS_W1 = WS_WOUT + (size_t)DM * DM * 2;
constexpr size_t WS_W2 = WS_W1 + (size_t)DFF * DM * 2;
constexpr size_t WS_XSC = 27 * MiB;
constexpr size_t WS_ACT = 35 * MiB;
constexpr size_t WS_G = 71 * MiB;
constexpr size_t WS_P = 74 * MiB;
constexpr size_t WS_OG = 182 * MiB;
constexpr size_t WS_H = 74 * MiB;
constexpr size_t WS_SLAB = 218 * MiB;
constexpr size_t WS_END = 254 * MiB;
static_assert(WS_H + (size_t)NT * DFF * 2 <= WS_SLAB && WS_SLAB + (size_t)128 * 65536 * 4 <= WS_END, "slabs");
static_assert(WS_W2 + (size_t)DM * DFF * 2 <= WS_XSC, "weights");
static_assert(WS_H + (size_t)NT * DFF * 2 <= WS_END && WS_OG + (size_t)2 * NT * 512 * 4 <= WS_END, "ws map");
constexpr int CW_BAR = 4096;

constexpr int LDS_BYTES = 147456;
constexpr int MISC_OFF = LDS_BYTES - 512;
static_assert(91712 <= MISC_OFF, "GDN LDS map");

__device__ __forceinline__ unsigned f2bf(float f) { unsigned u = __builtin_bit_cast(unsigned, f); return (u + 0x7fffu + ((u >> 16) & 1u)) >> 16; }
__device__ __forceinline__ unsigned pk2(float lo, float hi) { return f2bf(lo) | (f2bf(hi) << 16); }
__device__ __forceinline__ float bf2f(bf16 v) { return __builtin_bit_cast(float, (unsigned)v << 16); }
__device__ __forceinline__ float bfs2f(short v) { return __builtin_bit_cast(float, ((unsigned)(unsigned short)v) << 16); }
__device__ __forceinline__ float lane_xor(float v, int o, int lane) { return __builtin_bit_cast(float, __builtin_amdgcn_ds_bpermute((lane ^ o) << 2, __builtin_bit_cast(int, v))); }
__device__ __forceinline__ float wave_sum_l(float v, int lane) {
#pragma unroll
    for (int o = 1; o < 64; o <<= 1) v += lane_xor(v, o, lane);
    return v;
}
__device__ __forceinline__ float wave_max_l(float v, int lane) {
#pragma unroll
    for (int o = 1; o < 64; o <<= 1) v = fmaxf(v, lane_xor(v, o, lane));
    return v;
}
#define wave_sum(v) wave_sum_l((v), c.lane)
#define wave_max(v) wave_max_l((v), c.lane)
__device__ __forceinline__ float siluf(float v) { return v / (1.f + __expf(-v)); }

#define XB_TMO      128
#define XB_XCNT(j)  (256  + 64 * (j))
#define XB_XSUB(j)  (1280 + 64 * (j))
#define XB_XGEN(j)  (2304 + 64 * (j))
#define XB_TOP      3328
#define XB_TOPGEN   3392
#define XCD_BAR_WORDS 3456
#define XB_SPIN_CAP (1u << 22)
__device__ __forceinline__ unsigned xb_ld(unsigned* p)              { return __hip_atomic_load(p, __ATOMIC_RELAXED, __HIP_MEMORY_SCOPE_AGENT); }
__device__ __forceinline__ unsigned xb_add(unsigned* p, unsigned v) { return __hip_atomic_fetch_add(p, v, __ATOMIC_RELAXED, __HIP_MEMORY_SCOPE_AGENT); }
__device__ __forceinline__ unsigned xb_xcc_id() { return (unsigned)__builtin_amdgcn_s_getreg((3 << 11) | 20) & 0xFu; }
#define XB_SPIN(cond, bar) do { unsigned _sp = 0; while (cond) { __builtin_amdgcn_s_sleep(1); \
    if ((++_sp & 255u) == 0u) { if (xb_ld(&(bar)[XB_TMO])) break; if (_sp > XB_SPIN_CAP) { atomicAdd(&(bar)[XB_TMO], 1u); break; } } } } while (0)
struct XcdBarrier { unsigned* bar; unsigned x; volatile LAS unsigned* st; };
__device__ __forceinline__ XcdBarrier xcd_barrier_post(unsigned* bar, volatile LAS unsigned* st, bool leader) {
    XcdBarrier b; b.bar = bar; b.x = xb_xcc_id(); b.st = st;
    if (leader) (void)xb_add(&bar[XB_XCNT(b.x)], 1u);
    return b;
}
__device__ __forceinline__ void xcd_barrier_complete(unsigned* bar, unsigned x, unsigned& nloc, unsigned& nx) {
    const unsigned G = gridDim.x * gridDim.y * gridDim.z;
    unsigned sum, cnt, mine, sp = 0u;
    for (;;) {
        sum = 0u; cnt = 0u; mine = 0u;
#pragma unroll 1
        for (unsigned j = 0; j < 16; ++j) { const unsigned c = xb_ld(&bar[XB_XCNT(j)]); sum += c; cnt += (c > 0u) ? 1u : 0u; mine = (j == x) ? c : mine; }
        if (sum == G) break;
        __builtin_amdgcn_s_sleep(1);
        if ((++sp & 255u) == 0u) { if (xb_ld(&bar[XB_TMO])) break; if (sp > XB_SPIN_CAP) { atomicAdd(&bar[XB_TMO], 1u); break; } }
    }
    nloc = mine > 0u ? mine : 1u; nx = cnt > 0u ? cnt : 1u;
}
__device__ __forceinline__ void xcd_barrier(const XcdBarrier& b, bool leader) {
    asm volatile("s_waitcnt vmcnt(0)" ::: "memory");
    __syncthreads();
    if (leader) {
        unsigned* bar = b.bar; asm volatile("" : "+s"(bar));
        __builtin_amdgcn_s_waitcnt(0);
        unsigned nloc = b.st[0], nx = b.st[1];
        if (nloc == 0u) { xcd_barrier_complete(bar, b.x, nloc, nx); b.st[0] = nloc; b.st[1] = nx; }
        const unsigned old = xb_add(&bar[XB_XSUB(b.x)], 1u);
        const unsigned gen = old / nloc;
        if (old + 1u == (gen + 1u) * nloc) {
            __builtin_amdgcn_fence(__ATOMIC_RELEASE, "agent");
            asm volatile("s_waitcnt vmcnt(0)" ::: "memory");
            const unsigned og = xb_add(&bar[XB_TOP], 1u);
            const unsigned tg = og / nx;
            if (og + 1u == (tg + 1u) * nx) xb_add(&bar[XB_TOPGEN], 1u);
            else XB_SPIN(xb_ld(&bar[XB_TOPGEN]) == tg, bar);
            __builtin_amdgcn_fence(__ATOMIC_ACQUIRE, "agent");
            xb_add(&bar[XB_XGEN(b.x)], 1u);
            asm volatile("s_waitcnt vmcnt(0)" ::: "memory");
        } else {
            XB_SPIN(xb_ld(&bar[XB_XGEN(b.x)]) == gen, bar);
            __builtin_amdgcn_fence(__ATOMIC_ACQUIRE, "agent");
            asm volatile("s_waitcnt vmcnt(0)" ::: "memory");
        }
    }
    __syncthreads();
}

struct Args { const float* in[21]; float* out; unsigned char* ws; int ph_lo, ph_hi, li, pad; };
struct Ctx {
    LAS unsigned char* lds;
    int tid, lane, wave, G, bx, gw, NGW;
    const __attribute__((address_space(4))) Args* A;
};
#define c_in(i)  (c.A->in[i])
#define c_out    (c.A->out)
#define c_Win_t  ((bf16*)(c.A->ws + WS_WIN))
#define c_Wout_t ((bf16*)(c.A->ws + WS_WOUT))
#define c_W1_t   ((bf16*)(c.A->ws + WS_W1))
#define c_W2_t   ((bf16*)(c.A->ws + WS_W2))
#define c_ACT    ((bf16*)(c.A->ws + WS_ACT))
#define c_P      ((bf16*)(c.A->ws + WS_P))
#define c_H      ((bf16*)(c.A->ws + WS_H))
#define c_XSC    ((float*)(c.A->ws + WS_XSC))
#define c_Gt     ((float*)(c.A->ws + WS_G))
#define c_OG     ((float*)(c.A->ws + WS_OG))
#define c_MOD    ((float*)(c.A->ws + WS_MOD))
#define c_ROPE   ((float*)(c.A->ws + WS_ROPE))
__device__ __forceinline__ float* xs_row(const Ctx& c, int R) {
    const int b = R / TPB, tp = R - b * TPB;
    return tp < CTXL ? c_XSC + ((size_t)(b * CTXL + tp) << 10) : c_out + ((size_t)(b * SEQ + tp - CTXL) << 10);
}
__device__ __forceinline__ const float* in_row(const Ctx& c, int R) {
    const int b = R / TPB, tp = R - b * TPB;
    return tp < CTXL ? c_in(2) + ((size_t)(b * CTXL + tp) << 10) : c_in(0) + ((size_t)(b * SEQ + tp - CTXL) << 10);
}
__device__ __forceinline__ int mod_row(int R) { const int b = R / TPB, tp = R - b * TPB; return tp < CTXL ? 8 : b; }

__device__ __forceinline__ void transpose_item(const float* W, int K, int N, bf16* WT, int k0, int n0, int n0d, LAS float* scr, int lane) {
#pragma unroll 8
    for (int i = 0; i < 32; ++i) { const int kk = 2 * i + (lane >> 5); scr[kk * 33 + (lane & 31)] = W[(size_t)(k0 + kk) * N + n0 + (lane & 31)]; }
    LDS_WAIT(); asm volatile("" ::: "memory");
    const int cch = lane & 7;
#pragma unroll
    for (int j = 0; j < 4; ++j) { const int n = (lane >> 3) + 8 * j; const LAS float* s = scr + (8 * cch) * 33 + n;
        v4u o; o.x = pk2(s[0 * 33], s[1 * 33]); o.y = pk2(s[2 * 33], s[3 * 33]); o.z = pk2(s[4 * 33], s[5 * 33]); o.w = pk2(s[6 * 33], s[7 * 33]);
        *(GAS v4u*)(WT + (size_t)(n0d + n) * K + k0 + 8 * cch) = o; }
    LDS_WAIT(); asm volatile("" ::: "memory");
}
__device__ __forceinline__ void conv_weights(Ctx& c, int l) {
    LAS float* scr = (LAS float*)(c.lds + c.wave * 16384);
    constexpr int I_IN = 16 * 97, I_O = 16 * 32, I_1 = 16 * 128, I_2 = 64 * 32, NITEMS = I_IN + I_O + I_1 + I_2;
    const float* w_in = c_in(7) + (size_t)l * DM * DIN; const float* w_out = c_in(17) + (size_t)l * DM * DM;
    const float* w1 = c_in(19) + (size_t)l * DM * DFF; const float* w2 = c_in(20) + (size_t)l * DFF * DM;
    { unsigned zu_ = 0u; asm volatile("" : "+v"(zu_));
      for (int i = c.gw * 64 + c.lane; i < (NPG - DIN) * DM / 8; i += c.NGW * 64) ((v4u*)(c_Win_t + (size_t)DIN * DM))[i] = (v4u){zu_, zu_, zu_, zu_}; }
    for (int it = c.gw; it < NITEMS; it += c.NGW) {
        int r = it;
        if (r < I_IN) { const int kb = r / 97, nb = r % 97; const int nbd = nb < 64 ? nb : (nb == 64 ? 96 : nb - 1);
            transpose_item(w_in, DM, DIN, c_Win_t, 64 * kb, 32 * nb, 32 * nbd, scr, c.lane); continue; } r -= I_IN;
        if (r < I_O) { const int kb = r / 32, nb = r % 32; transpose_item(w_out, DM, DM, c_Wout_t, 64 * kb, 32 * nb, 32 * nb, scr, c.lane); continue; } r -= I_O;
        if (r < I_1) { const int kb = r / 128, nb = r % 128; transpose_item(w1, DM, DFF, c_W1_t, 64 * kb, 32 * nb, 32 * nb, scr, c.lane); continue; } r -= I_1;
        { const int kb = r / 32, nb = r % 32; transpose_item(w2, DFF, DM, c_W2_t, 64 * kb, 32 * nb, 32 * nb, scr, c.lane); }
    }
}
__device__ __forceinline__ void ada_mod_phase(Ctx& c) {
    LAS float* scond = (LAS float*)c.lds; LAS float* red = scond + 9 * 1024;
    if (c.bx < 192) {
        for (int i = c.tid; i < 9 * 1024; i += NTHREADS) { const int r = i >> 10, k = i & 1023; const float v = r < 8 ? c_in(1)[r * 1024 + k] : c_in(3)[k]; scond[i] = siluf(v); }
        __syncthreads();
        for (int u = c.bx; u < 192; u += c.G) {
            const int l = u / 96, cg = u % 96, col = cg * 64 + c.lane;
            const float* w = c_in(4) + (size_t)l * DM * NMODC + col;
            float acc[9];
#pragma unroll
            for (int r = 0; r < 9; ++r) acc[r] = 0.f;
            const int k0 = c.wave * 128;
#pragma unroll 4
            for (int k = k0; k < k0 + 128; ++k) { const float wv = w[(size_t)k * NMODC];
#pragma unroll
                for (int r = 0; r < 9; ++r) acc[r] += scond[r * 1024 + k] * wv; }
#pragma unroll
            for (int r = 0; r < 9; ++r) red[(c.wave * 9 + r) * 64 + c.lane] = acc[r];
            __syncthreads();
            for (int i = c.tid; i < 576; i += NTHREADS) { const int r = i >> 6, ln = i & 63; float s = 0.f;
#pragma unroll
                for (int w8 = 0; w8 < 8; ++w8) s += red[(w8 * 9 + r) * 64 + ln];
                const int cc = cg * 64 + ln; c_MOD[(size_t)(l * 9 + r) * NMODC + cc] = s + c_in(5)[l * NMODC + cc]; }
            __syncthreads();
        }
    }
    const int gid = c.bx * NTHREADS + c.tid;
    if (gid < 96 * 16) { const int pos = gid >> 4, i = gid & 15; const float inv = powf(10000.f, -(float)i / 16.f);
        const float p = (float)(pos < 32 ? pos : pos - 32); const float a = p * inv; c_ROPE[2 * gid] = cosf(a); c_ROPE[2 * gid + 1] = sinf(a); }
}

__device__ __forceinline__ void norm_phase(Ctx& c, int l, int which  ) {
    const float* g = (which == 0 ? c_in(6) : c_in(18)) + l * DM;
    const bool skip_ctx = (which == 1 && l == NL - 1);
    for (int R = c.gw; R < NT; R += c.NGW) {
        const int b = R / TPB, tp = R - b * TPB;
        if (skip_ctx && tp < CTXL) continue;
        const bool first = (l == 0 && which == 0);
        const float* src = first ? in_row(c, R) : xs_row(c, R);
        const f32x4* xr = (const f32x4*)src + c.lane;
        f32x4 v[4]; float ss = 0.f;
#pragma unroll
        for (int j = 0; j < 4; ++j) v[j] = xr[64 * j];
        if (tp < CTXL && ((which == 0 && l > 0) || (which == 1 && l < NL - 1))) {
            const float* gm = which == 0 ? c_MOD + (size_t)((l - 1) * 9 + 8) * NMODC + 5 * DM : c_MOD + (size_t)(l * 9 + 8) * NMODC + 2 * DM;
            const float* slab = (const float*)(c.A->ws + (which == 0 ? WS_SLAB : WS_OG));
#pragma unroll
            for (int j = 0; j < 4; ++j) { const float* sp = slab + ((size_t)((b * 4 + j) * 4) << 16) + tp * 256 + 4 * c.lane; f32x4 a = *(const f32x4*)sp;
#pragma unroll
                for (int ks = 1; ks < 4; ++ks) a += *(const f32x4*)(sp + ((size_t)ks << 16));
                v[j] = v[j] + *(const f32x4*)(gm + 4 * c.lane + 256 * j) * a; ((f32x4*)xs_row(c, R) + c.lane)[64 * j] = v[j]; } }
#pragma unroll
        for (int j = 0; j < 4; ++j) ss += (v[j].x * v[j].x + v[j].y * v[j].y) + (v[j].z * v[j].z + v[j].w * v[j].w);
        if (first) { f32x4* xo = (f32x4*)xs_row(c, R) + c.lane;
#pragma unroll
            for (int j = 0; j < 4; ++j) xo[64 * j] = v[j]; }
        const float rstd = rsqrtf(wave_sum(ss) * (1.f / DM) + RMS_EPS);
        const int rb = tp < CTXL ? 8 : b;
        const float* mrow = c_MOD + (size_t)(l * 9 + rb) * NMODC + (which == 0 ? 0 : 3 * DM);
        unsigned long long* o8 = (unsigned long long*)(c_ACT + (size_t)R * DM) + c.lane;
#pragma unroll
        for (int j = 0; j < 4; ++j) { const int col = 4 * c.lane + 256 * j;
            const f32x4 gg = *(const f32x4*)(g + col), sh = *(const f32x4*)(mrow + col), sc = *(const f32x4*)(mrow + DM + col);
            const float y0 = v[j].x * rstd * gg.x * (1.f + sc.x) + sh.x, y1 = v[j].y * rstd * gg.y * (1.f + sc.y) + sh.y;
            const float y2 = v[j].z * rstd * gg.z * (1.f + sc.z) + sh.z, y3 = v[j].w * rstd * gg.w * (1.f + sc.w) + sh.w;
            o8[64 * j] = (unsigned long long)pk2(y0, y1) | ((unsigned long long)pk2(y2, y3) << 32); }
    }
}

template <class Epi>
__device__ __forceinline__ void gemm_naive(const Ctx& c, const bf16* A, const bf16* Bt, int M, int N, int K, const Epi& E, bool skip_ctx) {
    const int nN = N / 32, nM = M / 64, r = c.lane & 31, h = c.lane >> 5;
    for (int u = c.gw; u < nM * nN; u += c.NGW) {
        const int mt = u / nN, nt = u - mt * nN, row0 = mt * 64, col0 = nt * 32;
        if (skip_ctx && (row0 % TPB) < CTXL) continue;
        const bf16* a0 = A + (size_t)(row0 + r) * K + 8 * h; const bf16* a1 = a0 + (size_t)32 * K; const bf16* b0 = Bt + (size_t)(col0 + r) * K + 8 * h;
        f32x16 c0, c1;
#pragma unroll
        for (int i = 0; i < 16; ++i) { c0[i] = 0.f; c1[i] = 0.f; }
#pragma unroll 4
        for (int k = 0; k < K; k += 16) {
            const bf16x8 fa0 = *(const bf16x8*)(a0 + k), fa1 = *(const bf16x8*)(a1 + k), fb = *(const bf16x8*)(b0 + k);
            c0 = __builtin_amdgcn_mfma_f32_32x32x16_bf16(fa0, fb, c0, 0, 0, 0);
            c1 = __builtin_amdgcn_mfma_f32_32x32x16_bf16(fa1, fb, c1, 0, 0, 0);
        }
        E(c0, row0, col0 + r, h); E(c1, row0 + 32, col0 + r, h);
    }
}
struct EpiInProj { bf16* P; float* G;
    __device__ __forceinline__ void operator()(const f32x16& a, int row0, int col, int h) const {
#pragma unroll
        for (int i = 0; i < 16; ++i) { const int row = row0 + (i & 3) + 8 * (i >> 2) + 4 * h;
            if (col < NP) P[(size_t)row * NP + col] = (bf16)f2bf(a[i]); else G[(size_t)row * 32 + (col - NP)] = a[i]; } } };
struct EpiGates { float* G;
    __device__ __forceinline__ void operator()(const f32x16& a, int row0, int col, int h) const {
#pragma unroll
        for (int i = 0; i < 16; ++i) { const int row = row0 + (i & 3) + 8 * (i >> 2) + 4 * h; G[(size_t)row * 32 + col] = a[i]; } } };
struct EpiResid { const Ctx* c; const float* gate;
    __device__ __forceinline__ void operator()(const f32x16& a, int row0, int col, int h) const {
#pragma unroll
        for (int i = 0; i < 16; ++i) { const int row = row0 + (i & 3) + 8 * (i >> 2) + 4 * h;
            float* xr = xs_row(*c, row); const float gt = gate[(size_t)mod_row(row) * NMODC + col]; xr[col] += gt * a[i]; } } };
struct EpiRelu2 { bf16* H;
    __device__ __forceinline__ void operator()(const f32x16& a, int row0, int col, int h) const {
#pragma unroll
        for (int i = 0; i < 16; ++i) { const int row = row0 + (i & 3) + 8 * (i >> 2) + 4 * h; const float v = fmaxf(a[i], 0.f); H[(size_t)row * DFF + col] = (bf16)f2bf(v * v); } } };

namespace pg8 {
#define PG8_LAS __attribute__((address_space(3)))
typedef unsigned short bf16_t;
typedef short bf16x8 __attribute__((ext_vector_type(8)));
typedef float f32x4 __attribute__((ext_vector_type(4)));
typedef unsigned u32x4 __attribute__((ext_vector_type(4)));
constexpr int BM = 256, BK = 64, HALF = 128, HTB = HALF * BK * 2  , STAGE_BYTES = 8 * HTB, NXCD = 8, WGM = 8;

__host__ __device__ __forceinline__ int lds_byte(int r, int c) { const int st = (r >> 4) * 2 + (c >> 5), rr = r & 15, cc = c & 31, ob = rr * 64 + cc * 2; return st * 1024 + (ob ^ (((ob >> 9) & 1) << 5)); }
__host__ __device__ __forceinline__ void stage_rc(int b, int& R, int& C) { const int st = b / 1024, sb = b % 1024, swz = sb ^ (((sb >> 9) & 1) << 5); R = (st >> 1) * 16 + swz / 64; C = (st & 1) * 32 + (swz % 64) / 2; }
__host__ __device__ __forceinline__ int perm32(int rho) { const int n = rho >> 4, i = rho & 15; return 8 * (i >> 2) + 4 * n + (i & 3); }

struct Unit { int pm, pn, koff; };
struct Gemm { const bf16_t* A; const bf16_t* Bt; int M, N, K, ld; };

struct StaticOrder {
    int nM, nN, nwg, G, c;
    __host__ __device__ void init(int M, int N, int G_, int c_) { nM = M / BM; nN = N / BM; nwg = nM * nN; G = G_; c = c_; }
    __host__ __device__ bool next(int i, Unit& u) const {
        const long L = (long)i * G + c; if (L >= nwg) return false;
        int wgid = (int)L; { const int q = nwg / NXCD, r = nwg % NXCD, xcd = wgid % NXCD, off = wgid / NXCD; wgid = (xcd < r ? xcd * (q + 1) : r * (q + 1) + (xcd - r) * q) + off; }
        const int nig = WGM * nN, gid = wgid / nig, fm = gid * WGM, gsz = (nM - fm) < WGM ? (nM - fm) : WGM;
        u.pm = fm + ((wgid % nig) % gsz); u.pn = (wgid % nig) / gsz; u.koff = 0; return true;
    }
    __device__ __forceinline__ void a_ready(const Unit&) const {}
    __device__ __forceinline__ void done(const Unit&) const {}
};

__device__ __forceinline__ unsigned cvt_pk_bf16(float lo, float hi) { unsigned r; asm volatile("v_cvt_pk_bf16_f32 %0, %1, %2" : "=v"(r) : "v"(lo), "v"(hi)); return r; }
template <int ACT  > struct EpiBf16 {
    static constexpr bool PERM = true, AFTER_DRAIN = false; static_assert(ACT == 0 || ACT == 2, "EpiBf16: ACT is 0 (none) or 2 (squared relu)");
    bf16_t* O; int ldc; const float* bias; int split_cols; size_t split_stride; float scale0;
    __device__ __forceinline__ void operator()(const f32x4 (&acc)[2][2][4][2], const Unit& u, int wr, int wc, int fr, int fq) const {
        const int row0 = u.pm * BM + wr * 64 + fr; int colt = u.pn * BM; bf16_t* base = O;
        float sc = 1.f; if (split_cols) { const int t = colt / split_cols; base += (size_t)t * split_stride; colt -= t * split_cols; if (t == 0) sc = scale0; }
        const int col0 = colt + wc * 32 + 8 * fq, bcol0 = u.pn * BM + wc * 32 + 8 * fq;
        f32x4 bv[2][2]; float zf_ = 0.f; asm volatile("" : "+v"(zf_)); const f32x4 z4_ = (f32x4){zf_, zf_, zf_, zf_};
#pragma unroll
        for (int bj = 0; bj < 2; ++bj)
#pragma unroll
            for (int n = 0; n < 2; ++n) bv[bj][n] = bias ? *(const f32x4*)(bias + bcol0 + bj * HALF + 4 * n) : z4_;
#pragma unroll
        for (int ai = 0; ai < 2; ++ai)
#pragma unroll
            for (int m = 0; m < 4; ++m) { bf16_t* rowp = base + (size_t)(row0 + ai * HALF + m * 16) * ldc + col0;
#pragma unroll
                for (int bj = 0; bj < 2; ++bj) { f32x4 v0 = acc[ai][bj][m][0] + bv[bj][0], v1 = acc[ai][bj][m][1] + bv[bj][1];
                    if (ACT == 2) { v0 = __builtin_elementwise_max(v0, z4_); v1 = __builtin_elementwise_max(v1, z4_); v0 = v0 * v0; v1 = v1 * v1; }
                    v0 = v0 * sc; v1 = v1 * sc; u32x4 w; w.x = cvt_pk_bf16(v0[0], v0[1]); w.y = cvt_pk_bf16(v0[2], v0[3]); w.z = cvt_pk_bf16(v1[0], v1[1]); w.w = cvt_pk_bf16(v1[2], v1[3]);
                    *(u32x4*)(rowp + bj * HALF) = w; } }
    }
};

struct EpiInProjG {
    static constexpr bool PERM = true, AFTER_DRAIN = false;
    bf16_t* P; float* G;
    __device__ __forceinline__ void operator()(const f32x4 (&acc)[2][2][4][2], const Unit& u, int wr, int wc, int fr, int fq) const {
        const int row0 = u.pm * BM + wr * 64 + fr;
        if (u.pn < 12) {
            const int col0 = u.pn * BM + wc * 32 + 8 * fq;
#pragma unroll
            for (int ai = 0; ai < 2; ++ai)
#pragma unroll
                for (int m = 0; m < 4; ++m) { bf16_t* rowp = P + (size_t)(row0 + ai * HALF + m * 16) * 3072 + col0;
#pragma unroll
                    for (int bj = 0; bj < 2; ++bj) { const f32x4 v0 = acc[ai][bj][m][0], v1 = acc[ai][bj][m][1];
                        u32x4 w; w.x = cvt_pk_bf16(v0[0], v0[1]); w.y = cvt_pk_bf16(v0[2], v0[3]); w.z = cvt_pk_bf16(v1[0], v1[1]); w.w = cvt_pk_bf16(v1[2], v1[3]);
                        *(u32x4*)(rowp + bj * HALF) = w; } }
        } else if (wc == 0) {
#pragma unroll
            for (int ai = 0; ai < 2; ++ai)
#pragma unroll
                for (int m = 0; m < 4; ++m) { float* gp = G + (size_t)(row0 + ai * HALF + m * 16) * 32 + 8 * fq; *(f32x4*)gp = acc[ai][0][m][0]; *(f32x4*)(gp + 4) = acc[ai][0][m][1]; }
        }
    }
};
struct EpiGateRes {
    static constexpr bool PERM = false, AFTER_DRAIN = false;
    float* xsc; float* out; const float* gate;
    __device__ __forceinline__ void operator()(const f32x4 (&acc)[2][2][4][2], const Unit& u, int wr, int wc, int fr, int fq) const {
        const int b = u.pm / 9, seg = u.pm - 9 * b;
        float* base = seg == 0 ? xsc + ((size_t)(b * 256) << 10) : out + ((size_t)(b * 2048 + (seg - 1) * 256) << 10);
        const float* grow = gate + (size_t)(seg == 0 ? 8 : b) * 6144;
        const int col0 = u.pn * BM + wc * 32 + 4 * fq;
        f32x4 gv[2][2];
#pragma unroll
        for (int bj = 0; bj < 2; ++bj)
#pragma unroll
            for (int n = 0; n < 2; ++n) gv[bj][n] = *(const f32x4*)(grow + col0 + bj * HALF + n * 16);
#pragma unroll
        for (int ai = 0; ai < 2; ++ai)
#pragma unroll
            for (int m = 0; m < 4; ++m) { float* rowp = base + (size_t)(ai * HALF + wr * 64 + m * 16 + fr) * 1024 + col0;
#pragma unroll
                for (int bj = 0; bj < 2; ++bj)
#pragma unroll
                    for (int n = 0; n < 2; ++n) { f32x4* p = (f32x4*)(rowp + bj * HALF + n * 16); *p = *p + gv[bj][n] * acc[ai][bj][m][n]; }
                if (m & 1) asm volatile("" ::: "memory"); }
    }
};
struct CtxSplitOrder {
    int G, c, NS, kslice;
    __device__ void init(int G_, int c_, int NS_, int K) { G = G_; c = c_; NS = NS_; kslice = K / NS_; }
    __device__ bool next(int i, Unit& u) const { const int L = i * G + c; if (L >= 32 * NS) return false; const int t = L / NS, ks = L - t * NS; u.pm = 9 * (t >> 2); u.pn = t & 3; u.koff = ks * kslice; return true; }
    __device__ __forceinline__ void a_ready(const Unit&) const {}
    __device__ __forceinline__ void done(const Unit&) const {}
};
struct EpiSlab {
    static constexpr bool PERM = false, AFTER_DRAIN = false;
    float* slab; int NS, kslice;
    __device__ __forceinline__ void operator()(const f32x4 (&acc)[2][2][4][2], const Unit& u, int wr, int wc, int fr, int fq) const {
        float* base = slab + ((size_t)(((u.pm / 9) * 4 + u.pn) * NS + u.koff / kslice) << 16);
        const int col0 = wc * 32 + 4 * fq;
#pragma unroll
        for (int ai = 0; ai < 2; ++ai)
#pragma unroll
            for (int m = 0; m < 4; ++m) { float* rowp = base + (ai * HALF + wr * 64 + m * 16 + fr) * 256 + col0;
#pragma unroll
                for (int bj = 0; bj < 2; ++bj)
#pragma unroll
                    for (int n = 0; n < 2; ++n) *(f32x4*)(rowp + bj * HALF + n * 16) = acc[ai][bj][m][n]; }
    }
};
struct RowOrder {
    StaticOrder so; bool lat_only;
    __device__ void init(int N, int G_, int c_, bool lat) { lat_only = lat; so.init(lat ? 16384 : 18432, N, G_, c_); }
    __device__ bool next(int i, Unit& u) const { if (!so.next(i, u)) return false; if (lat_only) u.pm = 9 * (u.pm >> 3) + 1 + (u.pm & 7); return true; }
    __device__ __forceinline__ void a_ready(const Unit&) const {}
    __device__ __forceinline__ void done(const Unit&) const {}
};
template <class Epi, class Sched, bool ALIGN_EPI = false, bool SP2 = false>
__device__ __forceinline__ void gemm_phase(PG8_LAS unsigned char* lds, const Gemm g, const Sched& S, const Epi& E, const int tid) {
    const int wid = __builtin_amdgcn_readfirstlane(tid >> 6), lane = tid & 63, wr = wid >> 2, wc = wid & 3, fr = lane & 15, fq = lane >> 4;
    const int K = g.ld, nt = g.K / BK;
    float zf_ = 0.f; asm volatile("" : "+v"(zf_));
    unsigned voffA[2], voffB[2];
#pragma unroll
    for (int i = 0; i < 2; ++i) { int R, C; stage_rc(tid * 16 + i * 8192, R, C); const int Rb = Epi::PERM ? ((R & ~31) + perm32(R & 31)) : R;
        voffA[i] = (unsigned)(R * K + C) * 2u; voffB[i] = (unsigned)(Rb * K + C) * 2u; }
    const size_t kstep = (size_t)(BK * 2);
    const size_t hstep = (size_t)HALF * K * 2;
    const size_t tstep = 2 * hstep;
    const unsigned ldsw = (unsigned)wid * 1024u;
    const int aoff = lds_byte(wr * 64 + fr, fq * 8), boff = lds_byte(wc * 32 + fr, fq * 8);
#define PG8_SA(b, h) (((b) * 2 + (h)) * HTB)
#define PG8_SB(b, h) ((4 + (b) * 2 + (h)) * HTB)
#define PG8_STAGE(bufoff, gbase, voff) do { _Pragma("unroll") for (int _i = 0; _i < 2; ++_i) \
        __builtin_amdgcn_global_load_lds((const unsigned*)((const char*)(gbase) + (voff)[_i]), (PG8_LAS unsigned*)(lds + (bufoff) + ldsw + _i * 8192), 16, 0, 0); } while (0)
#define PG8_LDA(dst, b, h) do { _Pragma("unroll") for (int m = 0; m < 4; ++m) _Pragma("unroll") for (int k = 0; k < 2; ++k) dst[m][k] = *(const PG8_LAS bf16x8*)(lds + PG8_SA(b, h) + aoff + m * 2048 + k * 1024); } while (0)
#define PG8_LDB(dst, b, h) do { _Pragma("unroll") for (int n = 0; n < 2; ++n) _Pragma("unroll") for (int k = 0; k < 2; ++k) dst[n][k] = *(const PG8_LAS bf16x8*)(lds + PG8_SB(b, h) + boff + n * 2048 + k * 1024); } while (0)
#define PG8_MMA(ai, bj, At, Bt) do { __builtin_amdgcn_s_setprio(1); _Pragma("unroll") for (int m = 0; m < 4; ++m) _Pragma("unroll") for (int n = 0; n < 2; ++n) _Pragma("unroll") for (int k = 0; k < 2; ++k) \
        acc[ai][bj][m][n] = __builtin_amdgcn_mfma_f32_16x16x32_bf16(Bt[n][k], At[m][k], acc[ai][bj][m][n], 0, 0, 0); __builtin_amdgcn_s_setprio(0); } while (0)
#define PG8_WAIT_V(n) asm volatile("s_waitcnt vmcnt(" #n ")" ::: "memory")
#define PG8_WAIT_L(n) asm volatile("s_waitcnt lgkmcnt(" #n ")" ::: "memory")
#define PG8_BAR __builtin_amdgcn_s_barrier()
#define PG8_SCHED __builtin_amdgcn_sched_barrier(0)
    Unit cur, nxt; int ui = 0;
    if (!S.next(0, cur)) return;
    f32x4 acc[2][2][4][2];
#pragma unroll
    for (int a = 0; a < 2; ++a)
#pragma unroll
        for (int b = 0; b < 2; ++b)
#pragma unroll
            for (int m = 0; m < 4; ++m)
#pragma unroll
                for (int n = 0; n < 2; ++n) acc[a][b][m][n] = (f32x4){zf_, zf_, zf_, zf_};
    bf16x8 At[4][2], B0[2][2], B1[2][2];
    const char* cA = (const char*)g.A + (size_t)cur.pm * tstep + (size_t)cur.koff * 2; const char* cB = (const char*)g.Bt + (size_t)cur.pn * tstep + (size_t)cur.koff * 2;
    S.a_ready(cur);
    if constexpr (SP2) {
        PG8_STAGE(PG8_SB(0, 0), cB, voffB); PG8_STAGE(PG8_SB(0, 1), cB + hstep, voffB); PG8_STAGE(PG8_SA(0, 0), cA, voffA); PG8_STAGE(PG8_SA(0, 1), cA + hstep, voffA);
        if (wr == 1) PG8_BAR;
        PG8_WAIT_V(2); PG8_BAR;
        PG8_STAGE(PG8_SB(1, 0), cB + kstep, voffB); PG8_STAGE(PG8_SA(1, 0), cA + kstep, voffA); PG8_STAGE(PG8_SB(1, 1), cB + hstep + kstep, voffB);
        PG8_WAIT_V(6); PG8_BAR;
    } else {
        PG8_STAGE(PG8_SB(0, 0), cB, voffB); PG8_STAGE(PG8_SA(0, 0), cA, voffA); PG8_STAGE(PG8_SB(0, 1), cB + hstep, voffB); PG8_STAGE(PG8_SA(0, 1), cA + hstep, voffA);
        if (wr == 1) PG8_BAR;
        PG8_WAIT_V(4); PG8_BAR;
        PG8_STAGE(PG8_SB(1, 0), cB + kstep, voffB); PG8_STAGE(PG8_SA(1, 0), cA + kstep, voffA); PG8_STAGE(PG8_SB(1, 1), cB + hstep + kstep, voffB);
        PG8_WAIT_V(6); PG8_BAR;
    }
    for (;;) {
        const bool has_next = S.next(ui + 1, nxt);
        const char* nA = has_next ? (const char*)g.A + (size_t)nxt.pm * tstep + (size_t)nxt.koff * 2 : cA; const char* nB = has_next ? (const char*)g.Bt + (size_t)nxt.pn * tstep + (size_t)nxt.koff * 2 : cB;
        for (int t = 0; t < nt; t += 2) {
            const bool last = (t == nt - 2);
            const char* a1 = cA + (size_t)(t + 1) * kstep;
            const char* a2 = last ? nA : cA + (size_t)(t + 2) * kstep; const char* b2 = last ? nB : cB + (size_t)(t + 2) * kstep;
            const char* a3 = a2 + kstep; const char* b3 = b2 + kstep;
            if (last && has_next) S.a_ready(nxt);
            if constexpr (SP2) {
            PG8_LDB(B0, 0, 0); PG8_LDB(B1, 0, 1); PG8_SCHED; PG8_LDA(At, 0, 0); PG8_STAGE(PG8_SA(1, 1), a1 + hstep, voffA);
            PG8_WAIT_V(8); PG8_WAIT_L(0); PG8_BAR; PG8_MMA(0, 0, At, B0); PG8_MMA(0, 1, At, B1); PG8_BAR; PG8_SCHED;
            PG8_LDA(At, 0, 1); PG8_STAGE(PG8_SB(0, 0), b2, voffB); PG8_STAGE(PG8_SB(0, 1), b2 + hstep, voffB); PG8_STAGE(PG8_SA(0, 0), a2, voffA);
            PG8_WAIT_V(8); PG8_WAIT_L(0); PG8_BAR; PG8_MMA(1, 0, At, B0); PG8_MMA(1, 1, At, B1); PG8_BAR; PG8_SCHED;
            PG8_LDB(B0, 1, 0); PG8_LDB(B1, 1, 1); PG8_SCHED; PG8_LDA(At, 1, 0); PG8_STAGE(PG8_SA(0, 1), a2 + hstep, voffA);
            PG8_WAIT_V(8); PG8_WAIT_L(0); PG8_BAR; PG8_MMA(0, 0, At, B0); PG8_MMA(0, 1, At, B1); PG8_BAR; PG8_SCHED;
            PG8_LDA(At, 1, 1); PG8_STAGE(PG8_SB(1, 0), b3, voffB); PG8_STAGE(PG8_SB(1, 1), b3 + hstep, voffB); PG8_STAGE(PG8_SA(1, 0), a3, voffA);
            PG8_WAIT_V(8); PG8_WAIT_L(0); PG8_BAR; PG8_MMA(1, 0, At, B0); PG8_MMA(1, 1, At, B1); PG8_BAR; PG8_SCHED;
            } else {
            PG8_LDB(B0, 0, 0); PG8_SCHED; PG8_LDA(At, 0, 0); PG8_STAGE(PG8_SA(1, 1), a1 + hstep, voffA);
            PG8_WAIT_L(8); PG8_BAR; PG8_WAIT_L(0); PG8_MMA(0, 0, At, B0); PG8_BAR; PG8_SCHED;
            PG8_LDB(B1, 0, 1); PG8_STAGE(PG8_SB(0, 0), b2, voffB);
            PG8_BAR; PG8_WAIT_L(0); PG8_MMA(0, 1, At, B1); PG8_BAR;
            PG8_LDA(At, 0, 1); PG8_STAGE(PG8_SA(0, 0), a2, voffA);
            PG8_BAR; PG8_WAIT_L(0); PG8_MMA(1, 0, At, B0); PG8_BAR; PG8_SCHED;
            PG8_STAGE(PG8_SB(0, 1), b2 + hstep, voffB);
            PG8_WAIT_V(6); PG8_BAR; PG8_MMA(1, 1, At, B1); PG8_BAR;
            PG8_LDB(B0, 1, 0); PG8_SCHED; PG8_LDA(At, 1, 0); PG8_STAGE(PG8_SA(0, 1), a2 + hstep, voffA);
            PG8_WAIT_L(8); PG8_BAR; PG8_WAIT_L(0); PG8_MMA(0, 0, At, B0); PG8_BAR; PG8_SCHED;
            PG8_LDB(B1, 1, 1); PG8_STAGE(PG8_SB(1, 0), b3, voffB);
            PG8_BAR; PG8_WAIT_L(0); PG8_MMA(0, 1, At, B1); PG8_BAR;
            PG8_LDA(At, 1, 1); PG8_STAGE(PG8_SA(1, 0), a3, voffA);
            PG8_BAR; PG8_WAIT_L(0); PG8_MMA(1, 0, At, B0); PG8_BAR; PG8_SCHED;
            PG8_STAGE(PG8_SB(1, 1), b3 + hstep, voffB);
            PG8_WAIT_V(6); PG8_BAR; PG8_MMA(1, 1, At, B1); PG8_BAR;
            }
        }
        if constexpr (ALIGN_EPI) { if (wr == 0) PG8_BAR; }
        if constexpr (!Epi::AFTER_DRAIN) { E(acc, cur, wr, wc, fr, fq); S.done(cur); }
        if (!has_next) break;
#pragma unroll
        for (int a = 0; a < 2; ++a)
#pragma unroll
            for (int b = 0; b < 2; ++b)
#pragma unroll
                for (int m = 0; m < 4; ++m)
#pragma unroll
                    for (int n = 0; n < 2; ++n) acc[a][b][m][n] = (f32x4){zf_, zf_, zf_, zf_};
        cur = nxt; cA = nA; cB = nB; ++ui;
        if constexpr (ALIGN_EPI) { if (wr == 1) PG8_BAR; }
    }
    PG8_WAIT_V(0);
    if constexpr (!ALIGN_EPI) { if (wr == 0) PG8_BAR; }
    PG8_BAR;
    if constexpr (Epi::AFTER_DRAIN) { E.fused(acc, cur, wr, wc, fr, fq, lds, wid, lane); S.done(cur); }
#undef PG8_SA
#undef PG8_SB
#undef PG8_STAGE
#undef PG8_LDA
#undef PG8_LDB
#undef PG8_MMA
#undef PG8_WAIT_V
#undef PG8_WAIT_L
#undef PG8_BAR
#undef PG8_SCHED
}
}

__device__ __forceinline__ void attn_prep_phase(Ctx& c, int l, const bool dry = false) {
    const float* gq_b = c_in(12) + l * 64; const float* gk_b = c_in(13) + l * 64; const float* gq_c = c_in(14) + l * 64; const float* gk_c = c_in(15) + l * 64;
    const float* rope = c_ROPE; bf16* P = c_P; const int lane = c.lane;
    for (int it = c.gw; it < NT / 2; it += c.NGW) {
        bf16x8 raw[3];
#pragma unroll
        for (int k = 0; k < 3; ++k) { const int ch = lane + 64 * k, row = ch >= 96, cr = ch - 96 * row, rng = cr >= 48, cc = cr - 48 * rng;
            raw[k] = *(const bf16x8*)(P + (size_t)(2 * it + row) * NP + (rng ? PC_C : PC_B) + cc * 8); }
#pragma unroll
        for (int k = 0; k < 3; ++k) { const int ch = lane + 64 * k, row = ch >= 96, cr = ch - 96 * row, rng = cr >= 48, cc = cr - 48 * rng, jj = cc >> 3, p = cc & 7;
            const int R = 2 * it + row; const int tp = R % TPB; const bool isq = jj < 4;
            const float* gn = (rng ? (isq ? gq_c : gk_c) : (isq ? gq_b : gk_b)) + 8 * p;
            float x[8], ss = 0.f;
#pragma unroll
            for (int e = 0; e < 8; ++e) { x[e] = bfs2f(raw[k][e]); ss += x[e] * x[e]; }
            ss += lane_xor(ss, 1, lane); ss += lane_xor(ss, 2, lane); ss += lane_xor(ss, 4, lane);
            const float rstd = rsqrtf(ss * (1.f / 64.f) + RMS_EPS);
            const f32x4 g0 = *(const f32x4*)gn, g1 = *(const f32x4*)(gn + 4);
            float y[8];
#pragma unroll
            for (int e = 0; e < 8; ++e) y[e] = x[e] * rstd * (e < 4 ? g0[e] : g1[e - 4]);
            if (tp >= CTXL) { const int t = tp - CTXL; const int pos = p < 4 ? (t >> 6) : 32 + (t & 63);
                const float* rt = rope + 2 * (pos * 16 + 8 * (p & 1));
                const f32x4 r0 = *(const f32x4*)rt, r1 = *(const f32x4*)(rt + 4), r2 = *(const f32x4*)(rt + 8), r3 = *(const f32x4*)(rt + 12);
                const float cs[8] = {r0[0], r0[2], r1[0], r1[2], r2[0], r2[2], r3[0], r3[2]}, sn[8] = {r0[1], r0[3], r1[1], r1[3], r2[1], r2[3], r3[1], r3[3]};
#pragma unroll
                for (int e = 0; e < 8; ++e) { const float partner = lane_xor(y[e], 2, lane); y[e] = (p & 2) ? (y[e] * cs[e] + partner * sn[e]) : (y[e] * cs[e] - partner * sn[e]); } }
            const float sc = isq ? C2 : 1.f;
            v4u o; o.x = pk2(y[0] * sc, y[1] * sc); o.y = pk2(y[2] * sc, y[3] * sc); o.z = pk2(y[4] * sc, y[5] * sc); o.w = pk2(y[6] * sc, y[7] * sc);
            if (dry) o = __builtin_bit_cast(v4u, raw[k]);
            *(v4u*)(P + (size_t)R * NP + (rng ? PC_C : PC_B) + cc * 8) = o; }
    }
}

__device__ __forceinline__ void gdn_naive_unit(Ctx& c, int l, int u, LAS float* kq  ) {
    const int d = u & 1, h = (u >> 1) & 7, b = u >> 4, lane = c.lane;
    const float* cw = c_in(8) + (size_t)l * 5 * 1536;
    LAS float* wts = kq + 128;
#pragma unroll
    for (int j = 0; j < 5; ++j) { wts[(3 * j) * 64 + lane] = cw[j * 1536 + h * 64 + lane]; wts[(3 * j + 1) * 64 + lane] = cw[j * 1536 + 512 + h * 64 + lane]; wts[(3 * j + 2) * 64 + lane] = cw[j * 1536 + 1024 + h * 64 + lane]; }
    LDS_WAIT(); asm volatile("" ::: "memory");
    const float Aexp = __expf(c_in(9)[l * 16 + d * 8 + h]), dtb = c_in(10)[l * 16 + d * 8 + h];
    float S[64];
#pragma unroll
    for (int i = 0; i < 64; ++i) S[i] = 0.f;
    float* og = c_OG + (size_t)d * NT * 512;
    for (int seg = 0; seg < 2; ++seg) {
        const int len = seg ? SEQ : CTXL, base = b * TPB + (seg ? CTXL : 0);
        for (int i = 0; i < len; ++i) {
            const int t = d ? len - 1 - i : i; const int R = base + t;
            float qc = 0.f, kc = 0.f, vc = 0.f;
#pragma unroll
            for (int j = 0; j < 5; ++j) { const int tt = t + j - 2;
                if (tt >= 0 && tt < len) { const bf16* pr = c_P + (size_t)(base + tt) * NP + h * 64 + lane;
                    qc += wts[(3 * j) * 64 + lane] * bf2f(pr[0]); kc += wts[(3 * j + 1) * 64 + lane] * bf2f(pr[512]); vc += wts[(3 * j + 2) * 64 + lane] * bf2f(pr[1024]); } }
            qc = siluf(qc); kc = siluf(kc); vc = siluf(vc);
            const float q = qc * rsqrtf(wave_sum(qc * qc) + 1e-6f) * 0.125f, k = kc * rsqrtf(wave_sum(kc * kc) + 1e-6f);
            const float braw = c_Gt[(size_t)R * 32 + d * 8 + h], araw = c_Gt[(size_t)R * 32 + 16 + d * 8 + h] + dtb;
            const float beta = 1.f / (1.f + __expf(-braw));
            const float sp = araw > 20.f ? araw : log1pf(__expf(araw));
            const float a = __expf(-Aexp * sp);
            kq[lane] = k; kq[64 + lane] = q;
            LDS_WAIT(); asm volatile("" ::: "memory");
            float kS = 0.f;
#pragma unroll
            for (int i2 = 0; i2 < 64; ++i2) { S[i2] *= a; kS += kq[i2] * S[i2]; }
            const float vn = beta * (vc - kS);
            float o = 0.f;
#pragma unroll
            for (int i2 = 0; i2 < 64; ++i2) { S[i2] += kq[i2] * vn; o += kq[64 + i2] * S[i2]; }
            og[(size_t)R * 512 + h * 64 + lane] = o;
            LDS_WAIT(); asm volatile("" ::: "memory");
        }
    }
}

__device__ __forceinline__ void attn_naive_unit(Ctx& c, int l, int u, LAS float* sc  ) {
    const int typ = u & 1, hq = (u >> 1) & 3, R = u >> 3; const int lane = c.lane;
    const int b = R / TPB, tp = R - b * TPB; const bool isctx = tp < CTXL;
    if (isctx && l == NL - 1) return;
    const int pc = typ ? PC_C : PC_B, hkv = hq >> 1;
    const int tq = tp - CTXL;
    LAS float* qs = sc + 2304;
    qs[lane] = bf2f(c_P[(size_t)R * NP + pc + hq * 64 + lane]);
    LDS_WAIT(); asm volatile("" ::: "memory");
    float qv[64];
#pragma unroll
    for (int i = 0; i < 64; ++i) qv[i] = qs[i];
    int lo = CTXL, hi = CTXL;
    if (!isctx) { if (typ == 0) { lo = CTXL; hi = TPB; } else { lo = CTXL + (tq - 128 > 0 ? tq - 128 : 0); hi = CTXL + (tq + 128 < SEQ - 1 ? tq + 128 : SEQ - 1) + 1; } }
    const int nkA = CTXL, nkB = hi - lo, nk = nkA + nkB;
    const bf16* Kb = c_P + (size_t)b * TPB * NP + pc + 256 + hkv * 64;
    const bf16* Vb = Kb + 128;
    float mx = -INFINITY;
    for (int j0 = 0; j0 < nk; j0 += 64) {
        const int j = j0 + lane; float s = -INFINITY;
        if (j < nk) { const int kr = j < nkA ? j : lo + (j - nkA); const bf16x8* kp = (const bf16x8*)(Kb + (size_t)kr * NP); s = 0.f;
#pragma unroll
            for (int q8 = 0; q8 < 8; ++q8) { const bf16x8 kk = kp[q8];
#pragma unroll
                for (int e = 0; e < 8; ++e) s += qv[q8 * 8 + e] * bfs2f(kk[e]); } }
        sc[j] = s; mx = fmaxf(mx, s);
    }
    mx = wave_max(mx);
    float sinkl = 0.f;
    if (typ) { sinkl = c_in(16)[l * 4 + hq] * LOG2E; mx = fmaxf(mx, sinkl); }
    LDS_WAIT(); asm volatile("" ::: "memory");
    float lsum = 0.f;
    for (int j0 = 0; j0 < nk; j0 += 64) { const int j = j0 + lane; float p = 0.f; if (j < nk) p = exp2f(sc[j] - mx); sc[j] = p; lsum += p; }
    lsum = wave_sum(lsum);
    if (typ) lsum += exp2f(sinkl - mx);
    LDS_WAIT(); asm volatile("" ::: "memory");
    float o = 0.f;
    for (int j = 0; j < nkA; ++j) o += sc[j] * bf2f(Vb[(size_t)j * NP + lane]);
    for (int j = 0; j < nkB; ++j) o += sc[nkA + j] * bf2f(Vb[(size_t)(lo + j) * NP + lane]);
    c_ACT[(size_t)R * DM + 512 + typ * 256 + hq * 64 + lane] = (bf16)f2bf(o / lsum);
    LDS_WAIT(); asm volatile("" ::: "memory");
}
__device__ __forceinline__ void mixer_naive_phase(Ctx& c, int l) {
    LAS float* wl = (LAS float*)c.lds + c.wave * 2432;
    const bool gdn_wave = (c.wave == 0 && c.bx < 128);
    if (gdn_wave) { gdn_naive_unit(c, l, c.bx, wl); return; }
    const int aw = c.bx * NWAVES + c.wave - (c.bx < 128 ? c.bx + 1 : 128);
    const int NAW = c.G * NWAVES - (c.G < 128 ? c.G : 128);
    for (int u = aw; u < NT * 8; u += NAW) attn_naive_unit(c, l, u, wl);
}

#ifndef ATTN_STORE16
#define ATTN_STORE16(p,v) (*(u32x4*)(p)=(v))
#endif
namespace attn_body {
using bf16=unsigned short;
using bf16x8=__attribute__((ext_vector_type(8)))short;
using s16x4=__attribute__((ext_vector_type(4)))short;
using f32x16=__attribute__((ext_vector_type(16)))float;
using u32x4=__attribute__((ext_vector_type(4)))unsigned;
constexpr int D=64,QP=3072,OP=1024;
constexpr int NW=8,QBLK=32,QB=QBLK*NW,KVBLK=64;
__device__ __forceinline__ int crow(int r,int hi){return (r&3)+8*(r>>2)+4*hi;}
#define SBAR() __builtin_amdgcn_sched_barrier(0)
__device__ __forceinline__ void wmask(f32x16&p0,f32x16&p1,int rel,int hi){
  const float NEG=-INFINITY; const int kb=rel+4*hi;
  #pragma unroll
  for(int r=0;r<16;++r){const int kv=kb+(r&3)+8*(r>>2); if(kv>128||kv<-128)p0[r]=NEG; if(kv+32>128||kv+32<-128)p1[r]=NEG;}
}

constexpr int NSLOT=3, SLOTB=8192;
constexpr int LDS_K=0, LDS_V=NSLOT*SLOTB, LDS_WS=2*NSLOT*SLOTB, LDS_OST=LDS_WS+NW*64*4, LDS_BYTES=LDS_OST+NW*4096;
constexpr float C2=0.125f*1.4426950408889634f;
__device__ __forceinline__ void glds16(const void*gsrc,unsigned lds_dst){unsigned keep;
  asm volatile("s_mov_b32 %0, m0\n\ts_mov_b32 m0, %2\n\ts_nop 0\n\tglobal_load_lds_dwordx4 %1, off\n\ts_mov_b32 m0, %0":"=&s"(keep):"v"(gsrc),"s"(lds_dst):"memory");}
__device__ __forceinline__ float max3f(float a,float b,float c){float r;asm("v_max3_f32 %0, %1, %2, %3":"=v"(r):"v"(a),"v"(b),"v"(c));return r;}
__device__ __forceinline__ float max2f(float a,float b){float r;asm("v_max_f32_e32 %0, %1, %2":"=v"(r):"v"(a),"v"(b));return r;}
__device__ __forceinline__ float fadd_s(float a,float b){float r;asm("v_add_f32_e32 %0, %1, %2":"=v"(r):"v"(a),"v"(b));return r;}
__device__ __forceinline__ float fsub_s(float a,float b){float r;asm("v_sub_f32_e32 %0, %1, %2":"=v"(r):"v"(a),"v"(b));return r;}
typedef float f32x2_t __attribute__((ext_vector_type(2))); typedef __bf16 bf16x2_t __attribute__((ext_vector_type(2)));
__device__ __forceinline__ unsigned cvtpk_s(float lo,float hi){f32x2_t v={lo,hi};bf16x2_t b=__builtin_convertvector(v,bf16x2_t);return __builtin_bit_cast(unsigned,b);}
#define WAIT_BAR(N) asm volatile("s_waitcnt vmcnt(" #N ") lgkmcnt(0)\n\ts_barrier":::"memory")

__device__ __forceinline__ void qkt(f32x16&p0,f32x16&p1,const char*Kslot,const bf16x8*qr,const f32x16&negm,int r32,int hi){
  const char*kb=Kslot+hi*1024+r32*16;
  #pragma unroll
  for(int d0=0;d0<4;++d0){
    const bf16x8 b0=*reinterpret_cast<const bf16x8*>(kb+d0*2048);
    const bf16x8 b1=*reinterpret_cast<const bf16x8*>(kb+d0*2048+512);
    if(d0==0){p0=__builtin_amdgcn_mfma_f32_32x32x16_bf16(b0,qr[0],negm,0,0,0);p1=__builtin_amdgcn_mfma_f32_32x32x16_bf16(b1,qr[0],negm,0,0,0);}
    else{p0=__builtin_amdgcn_mfma_f32_32x32x16_bf16(b0,qr[d0],p0,0,0,0);p1=__builtin_amdgcn_mfma_f32_32x32x16_bf16(b1,qr[d0],p1,0,0,0);}}
}
typedef __attribute__((address_space(3))) const char* lds_cptr;
typedef short v4i16_t __attribute__((ext_vector_type(4)));
__device__ __forceinline__ void kload8(bf16x8*kf,lds_cptr kp){
  kf[0]=*(const __attribute__((address_space(3))) bf16x8*)(kp);      kf[1]=*(const __attribute__((address_space(3))) bf16x8*)(kp+512);
  kf[2]=*(const __attribute__((address_space(3))) bf16x8*)(kp+2048); kf[3]=*(const __attribute__((address_space(3))) bf16x8*)(kp+2560);
  kf[4]=*(const __attribute__((address_space(3))) bf16x8*)(kp+4096); kf[5]=*(const __attribute__((address_space(3))) bf16x8*)(kp+4608);
  kf[6]=*(const __attribute__((address_space(3))) bf16x8*)(kp+6144); kf[7]=*(const __attribute__((address_space(3))) bf16x8*)(kp+6656);
}
__device__ __forceinline__ void kload2(bf16x8*kf,lds_cptr kp,int j){ kf[2*j]=*(const __attribute__((address_space(3))) bf16x8*)(kp+j*2048); kf[2*j+1]=*(const __attribute__((address_space(3))) bf16x8*)(kp+j*2048+512); }
__device__ __forceinline__ s16x4 vtr(lds_cptr p){ return __builtin_bit_cast(s16x4,__builtin_amdgcn_ds_read_tr16_b64_v4i16((__attribute__((address_space(3))) v4i16_t*)p)); }
__device__ __forceinline__ float rowmax(const f32x16&p0,const f32x16&p1){
  float a=max3f(p0[0],p0[1],p1[0]),b=max3f(p0[2],p0[3],p1[1]);a=max3f(a,p1[2],p1[3]);
  #pragma unroll
  for(int r=4;r<16;r+=4){a=max3f(a,p0[r],p0[r+1]);b=max3f(b,p0[r+2],p0[r+3]);a=max3f(a,p1[r],p1[r+1]);b=max3f(b,p1[r+2],p1[r+3]);}
  const float m=max2f(a,b);
  auto rr=__builtin_amdgcn_permlane32_swap(__float_as_uint(m),__float_as_uint(m),false,false);
  return max2f(__uint_as_float(rr[0]),__uint_as_float(rr[1]));
}
__device__ __forceinline__ void pv(f32x16*o,int vb,bf16x8 pa0,bf16x8 pa1,bf16x8 pa2,bf16x8 pa3){
  #pragma unroll
  for(int d0=0;d0<2;++d0){s16x4 lo[4],hi[4];
    #pragma unroll
    for(int ks=0;ks<4;++ks){
      asm volatile("ds_read_b64_tr_b16 %0,%1 offset:%c2":"=&v"(lo[ks]):"v"(vb),"i"(d0*4096+ks*1024):"memory");
      asm volatile("ds_read_b64_tr_b16 %0,%1 offset:%c2":"=&v"(hi[ks]):"v"(vb),"i"(d0*4096+ks*1024+512):"memory");}
    asm volatile("s_waitcnt lgkmcnt(0)":::"memory");SBAR();
    #define PK(k) (bf16x8){lo[k][0],lo[k][1],lo[k][2],lo[k][3],hi[k][0],hi[k][1],hi[k][2],hi[k][3]}
    o[d0]=__builtin_amdgcn_mfma_f32_32x32x16_bf16(pa0,PK(0),o[d0],0,0,0);
    o[d0]=__builtin_amdgcn_mfma_f32_32x32x16_bf16(pa1,PK(1),o[d0],0,0,0);
    o[d0]=__builtin_amdgcn_mfma_f32_32x32x16_bf16(pa2,PK(2),o[d0],0,0,0);
    o[d0]=__builtin_amdgcn_mfma_f32_32x32x16_bf16(pa3,PK(3),o[d0],0,0,0);
    #undef PK
  }
}

#ifndef ATTN_STORE16
#define ATTN_STORE16(p,v) (*(u32x4*)(p)=(v))
#endif
template<int THRL> __device__ __forceinline__ void attn_unit(const bf16*Qrow0,const bf16*__restrict__ Kh,const bf16*__restrict__ Vh,bf16*Orow0,const int NT,const int woff,const int kq0,const float sinkl,const bool has_sink,const bool domask,char*shm,const int tid){
  const int lane=tid&63,r32=lane&31,hi=lane>>5; const int wid=__builtin_amdgcn_readfirstlane(tid>>6);
  const bf16*Qw=Qrow0+(long)(wid*QBLK)*QP;
  const unsigned lds0=(unsigned)(uintptr_t)shm;
  float*wsf=(float*)(shm+LDS_WS)+wid*64;
  const bf16*ksrc=Kh+(long)lane*QP+wid*8;
  const bf16*vsrc=Vh+(long)(16*(wid&3)+(lane>>2))*QP+(wid>>2)*32+(lane&3)*8;
  const unsigned kdst=lds0+LDS_K+wid*1024, vdst=lds0+LDS_V+wid*1024;
  #define KROW(t) (KVBLK*(t)+(((t)>=4)?woff:0))
  #define DMA_K(t,slot) glds16(ksrc+(long)KROW(t)*QP,(unsigned)__builtin_amdgcn_readfirstlane(kdst+(slot)))
  #define DMA_V(t,slot) glds16(vsrc+(long)KROW(t)*QP,(unsigned)__builtin_amdgcn_readfirstlane(vdst+(slot)))
  const int vb0=(int)(lds0+LDS_V)+((lane>>4)&1)*32+(lane&3)*8+(4*hi+((lane&15)>>2))*64;
  const char*Kbase=shm+LDS_K; bf16x8 kf[8];
  const lds_cptr shm3=(lds_cptr)shm; const lds_cptr kp0=shm3+LDS_K+hi*1024+r32*16; const lds_cptr vp0=shm3+LDS_V+((lane>>4)&1)*32+(lane&3)*8+(4*hi+((lane&15)>>2))*64;
  DMA_K(0,0);DMA_V(0,0);DMA_K(1,SLOTB);
  bf16x8 qr[4];
  #pragma unroll
  for(int d0=0;d0<4;++d0)qr[d0]=*reinterpret_cast<const bf16x8*>(&Qw[(long)r32*QP+d0*16+hi*8]);
  float mhat=0.f,l_reg=0.f;f32x16 o[2];o[0]=f32x16{};o[1]=f32x16{};f32x16 negm=f32x16{};asm volatile("":"+v"(negm));
  const int qrel=wid*QBLK+r32;
  #define CMASK(P0,P1,t) do{ if(domask&&(t)>=4) wmask(P0,P1,kq0+KVBLK*(t)-qrel,hi); }while(0)
  bool resc=false;
  #define START(P0,P1) do{ const float rm=rowmax(P0,P1); resc=false; \
    { const float dl=rm; mhat=fadd_s(mhat,dl); \
      _Pragma("unroll") for(int r=0;r<16;++r){P0[r]=fsub_s(P0[r],dl);P1[r]=fsub_s(P1[r],dl);} \
      _Pragma("unroll") for(int r=0;r<16;++r)negm[r]=-mhat; asm volatile("":"+v"(negm)); } \
    _Pragma("unroll") for(int r=0;r<16;++r)P0[r]=__builtin_amdgcn_exp2f(P0[r]); }while(0)
  #define RESC() do{ if(resc){ asm volatile("s_waitcnt lgkmcnt(0)":::"memory"); \
      _Pragma("unroll") for(int d_=0;d_<2;++d_) _Pragma("unroll") for(int r=0;r<16;++r)o[d_][r]*=wsf[crow(r,hi)]; } }while(0)
  f32x16 pA0,pA1,pB0,pB1;
  int sl_prev=0,sl_cur=0,sl_next=SLOTB;
  #define ROT() do{sl_prev=sl_cur;sl_cur=sl_next;sl_next=(sl_next==(NSLOT-1)*SLOTB)?0:sl_next+SLOTB;}while(0)
  DMA_K(2,2*SLOTB);
  WAIT_BAR(3);
  qkt(pA0,pA1,Kbase,qr,negm,r32,hi);asm volatile("s_nop 15\n\ts_nop 7":"+v"(pA0),"+v"(pA1));CMASK(pA0,pA1,0);
  START(pA0,pA1);
  _Pragma("unroll") for(int r=0;r<16;++r)pA1[r]=__builtin_amdgcn_exp2f(pA1[r]);
  WAIT_BAR(0);
  DMA_K(3,0);DMA_V(1,SLOTB);
  ROT();
  kload8(kf,kp0+sl_cur);
  WAIT_BAR(2);
  s16x4 vlo[8],vhi[8]; u32x4 pw0,pw1,pw2,pw3;
  #define PKW(P,B) cvtpk_s(P[B],P[B+1])
  #define PAF(k) __builtin_bit_cast(bf16x8,pw##k)
  #define VFR(i) (bf16x8){vlo[i][0],vlo[i][1],vlo[i][2],vlo[i][3],vhi[i][0],vhi[i][1],vhi[i][2],vhi[i][3]}
  #define PIN(x) asm volatile("":"+v"(x))
  #define MX3(a,b,c) __builtin_fmaxf(__builtin_fmaxf((a),(b)),(c))
  #define GAPA(MF,A0,A1,A2,A3,W0,W1,PW) do{ MF; sacc+=A0; sacc+=A1; sacc+=A2; sacc+=A3; PIN(sacc); W0; W1; PIN(PW); SBAR(); }while(0)
  #define EX(v) __builtin_amdgcn_exp2f(v)
  #define GAPB(MF,X,B) do{ MF; X[B]=EX(X[B]); X[B+1]=EX(X[B+1]); X[B+2]=EX(X[B+2]); X[B+3]=EX(X[B+3]); PIN(X); SBAR(); }while(0)
  #define VRD(i) do{ vlo[i]=vtr(vp_+(((i)>>2)*4096+((i)&3)*1024)); vhi[i]=vtr(vp_+(((i)>>2)*4096+((i)&3)*1024+512)); }while(0)
  #define KRD(G,j) do{ if(G){ kload2(kf,kp0+sl_next,j); SBAR(); } }while(0)
  #define STEP(C0,C1,P0,P1,t,GK,GV,GL) do{ SBAR(); \
    const lds_cptr vp_=vp0+sl_prev; \
    VRD(0); SBAR(); float sacc=(P0[0]+P0[1]); \
    GAPA(C0=__builtin_amdgcn_mfma_f32_32x32x16_bf16(kf[0],qr[0],negm,0,0,0), P0[2],P0[3],P0[4],P0[5],     pw0[0]=PKW(P0,0), pw0[1]=PKW(P0,2), pw0); \
    VRD(4); SBAR(); GAPA(C1=__builtin_amdgcn_mfma_f32_32x32x16_bf16(kf[1],qr[0],negm,0,0,0), P0[6],P0[7],P0[8],P0[9],     pw0[2]=PKW(P0,4), pw0[3]=PKW(P0,6), pw0); \
    VRD(1); SBAR(); GAPA(C0=__builtin_amdgcn_mfma_f32_32x32x16_bf16(kf[2],qr[1],C0,0,0,0),   P0[10],P0[11],P0[12],P0[13], pw1[0]=PKW(P0,8), pw1[1]=PKW(P0,10), pw1); \
    VRD(5); SBAR(); GAPA(C1=__builtin_amdgcn_mfma_f32_32x32x16_bf16(kf[3],qr[1],C1,0,0,0),   P0[14],P0[15],P1[0],P1[1],   pw1[2]=PKW(P0,12),pw1[3]=PKW(P0,14), pw1); \
    VRD(2); SBAR(); GAPA(C0=__builtin_amdgcn_mfma_f32_32x32x16_bf16(kf[4],qr[2],C0,0,0,0),   P1[2],P1[3],P1[4],P1[5],     pw2[0]=PKW(P1,0), pw2[1]=PKW(P1,2), pw2); \
    VRD(6); SBAR(); GAPA(C1=__builtin_amdgcn_mfma_f32_32x32x16_bf16(kf[5],qr[2],C1,0,0,0),   P1[6],P1[7],P1[8],P1[9],     pw2[2]=PKW(P1,4), pw2[3]=PKW(P1,6), pw2); \
    VRD(3); SBAR(); GAPA(C0=__builtin_amdgcn_mfma_f32_32x32x16_bf16(kf[6],qr[3],C0,0,0,0),   P1[10],P1[11],P1[12],P1[13], pw3[0]=PKW(P1,8), pw3[1]=PKW(P1,10), pw3); \
    VRD(7); SBAR(); GAPA(C1=__builtin_amdgcn_mfma_f32_32x32x16_bf16(kf[7],qr[3],C1,0,0,0),   P1[14],P1[15],0.f,0.f,       pw3[2]=PKW(P1,12),pw3[3]=PKW(P1,14), pw3); \
    l_reg+=sacc; \
    if(GK){DMA_K((t)+3,sl_cur);} if(GV){DMA_V((t)+1,sl_next);} \
    CMASK(C0,C1,t); \
    { float a=MX3(C0[0],C0[1],C1[0]),b=MX3(C0[2],C0[3],C1[1]); a=MX3(a,C1[2],C1[3]); \
      _Pragma("unroll") for(int r=4;r<16;r+=4){a=MX3(a,C0[r],C0[r+1]);b=MX3(b,C0[r+2],C0[r+3]);a=MX3(a,C1[r],C1[r+1]);b=MX3(b,C1[r+2],C1[r+3]);} \
      float rm=__builtin_fmaxf(a,b); { auto rr=__builtin_amdgcn_permlane32_swap(__float_as_uint(rm),__float_as_uint(rm),false,false); rm=__builtin_fmaxf(__uint_as_float(rr[0]),__uint_as_float(rr[1])); } \
      resc=false; \
      if(__builtin_expect(__any(rm>(float)THRL),0)){ const float dl=__builtin_fmaxf(rm,0.f); mhat+=dl; \
        _Pragma("unroll") for(int r=0;r<16;++r){C0[r]-=dl;C1[r]-=dl;} \
        _Pragma("unroll") for(int r=0;r<16;++r)negm[r]=-mhat; asm volatile("":"+v"(negm)); \
        const float f=__builtin_amdgcn_exp2f(-dl); l_reg*=f; if(hi==0)wsf[r32]=f; resc=true; } } \
    SBAR(); \
    GAPB(o[0]=__builtin_amdgcn_mfma_f32_32x32x16_bf16(PAF(0),VFR(0),o[0],0,0,0), C0,0); \
    GAPB(o[1]=__builtin_amdgcn_mfma_f32_32x32x16_bf16(PAF(0),VFR(4),o[1],0,0,0), C0,4); \
    KRD(GL,0); GAPB(o[0]=__builtin_amdgcn_mfma_f32_32x32x16_bf16(PAF(1),VFR(1),o[0],0,0,0), C0,8); \
    KRD(GL,1); GAPB(o[1]=__builtin_amdgcn_mfma_f32_32x32x16_bf16(PAF(1),VFR(5),o[1],0,0,0), C0,12); \
    KRD(GL,2); GAPB(o[0]=__builtin_amdgcn_mfma_f32_32x32x16_bf16(PAF(2),VFR(2),o[0],0,0,0), C1,0); \
    KRD(GL,3); GAPB(o[1]=__builtin_amdgcn_mfma_f32_32x32x16_bf16(PAF(2),VFR(6),o[1],0,0,0), C1,4); \
    GAPB(o[0]=__builtin_amdgcn_mfma_f32_32x32x16_bf16(PAF(3),VFR(3),o[0],0,0,0), C1,8); \
    GAPB(o[1]=__builtin_amdgcn_mfma_f32_32x32x16_bf16(PAF(3),VFR(7),o[1],0,0,0), C1,12); \
    }while(0)
  int t=1;
  for(;t+5<NT;t+=2){
    STEP(pB0,pB1,pA0,pA1,t,true,true,true);     WAIT_BAR(2); RESC(); ROT();
    STEP(pA0,pA1,pB0,pB1,t+1,true,true,true);   WAIT_BAR(2); RESC(); ROT();
  }
  #define ENDW(tt) do{ if((tt)+3<NT){WAIT_BAR(2);} else if((tt)+2<NT){WAIT_BAR(1);} else {WAIT_BAR(0);} }while(0)
  for(;t+1<NT;t+=2){
    STEP(pB0,pB1,pA0,pA1,t,(t+3<NT),(t+1<NT),(t+1<NT));       ENDW(t);   RESC(); ROT();
    STEP(pA0,pA1,pB0,pB1,t+1,(t+4<NT),(t+2<NT),(t+2<NT));     ENDW(t+1); RESC(); ROT();
  }
  STEP(pB0,pB1,pA0,pA1,NT-1,false,false,false); RESC();
  { float sacc=pB0[0]+pB0[1]; _Pragma("unroll") for(int r=2;r<16;++r)sacc+=pB0[r]; _Pragma("unroll") for(int r=0;r<16;++r)sacc+=pB1[r]; l_reg+=sacc;
    pw0=(u32x4){PKW(pB0,0),PKW(pB0,2),PKW(pB0,4),PKW(pB0,6)};pw1=(u32x4){PKW(pB0,8),PKW(pB0,10),PKW(pB0,12),PKW(pB0,14)};pw2=(u32x4){PKW(pB1,0),PKW(pB1,2),PKW(pB1,4),PKW(pB1,6)};pw3=(u32x4){PKW(pB1,8),PKW(pB1,10),PKW(pB1,12),PKW(pB1,14)};
    SBAR(); pv(o,vb0+sl_cur,PAF(0),PAF(1),PAF(2),PAF(3)); }
  #undef PKW
  #undef PAF
  #undef VFR
  #undef PIN
  #undef MX3
  #undef GAPA
  #undef GAPB
  #undef EX
  #undef VRD
  #undef KRD
  #undef STEP
  #undef ENDW
  {auto rr=__builtin_amdgcn_permlane32_swap(__float_as_uint(l_reg),__float_as_uint(l_reg),false,false);l_reg=__uint_as_float(rr[0])+__uint_as_float(rr[1]);}
  if(has_sink)l_reg+=__builtin_amdgcn_exp2f(sinkl-mhat);
  if(hi==0)wsf[32+r32]=l_reg;asm volatile("s_waitcnt lgkmcnt(0)":::"memory");
  float rli[16];
  #pragma unroll
  for(int r=0;r<16;++r)rli[r]=__builtin_amdgcn_rcpf(wsf[32+crow(r,hi)]);
  bf16*Ow=Orow0+(long)(wid*QBLK)*OP;
  { bf16*stg=(bf16*)(shm+LDS_OST)+wid*2048;
    #pragma unroll
    for(int r=0;r<16;++r){const int orow=crow(r,hi);
      #pragma unroll
      for(int d0=0;d0<2;++d0)stg[orow*64+d0*32+r32]=(bf16)(cvtpk_s(o[d0][r]*rli[r],0.f)&0xffffu);}
    asm volatile("s_waitcnt lgkmcnt(0)":::"memory");
    #pragma unroll
    for(int i=0;i<4;++i){const int row=i*8+(lane>>3),ch=lane&7; const u32x4 v=*(const u32x4*)(stg+row*64+ch*8); ATTN_STORE16(Ow+(long)row*OP+ch*8,v);} }
  asm volatile("s_waitcnt lgkmcnt(0)\n\ts_barrier":::"memory");
  #undef DMA_K
  #undef KROW
  #undef DMA_V
  #undef CMASK
  #undef START
  #undef RESC
  #undef ROT
}
constexpr int ATTN_LDS_BYTES=LDS_BYTES;
#undef SBAR
#undef WAIT_BAR
}

constexpr int CW_Q = 32768;
__device__ __forceinline__ void attn_item(Ctx& c, int l, int it, int g) {
    const bf16* P = c_P; bf16* MIX = c_ACT; char* shm = (char*)c.lds;
    int b, hq, pc, ocol, NTl, woff = 0, kq0 = 0; size_t qrow; bool sink = false, domask = false;
    if (it < 2) { b = g >> 5; hq = (g >> 3) & 3; const int qb = g & 7; qrow = (size_t)b * TPB + CTXL + qb * 256; pc = it ? PC_C : PC_B; ocol = 512 + it * 256 + hq * 64;
        if (it == 0) NTl = 36;
        else { const int w0 = 4 * qb - 2 > 0 ? 4 * qb - 2 : 0, we = 4 * qb + 5 < 31 ? 4 * qb + 5 : 31; NTl = 4 + we - w0 + 1; woff = w0 * 64; kq0 = (w0 - 4) * 64 - qb * 256; sink = true; domask = true; } }
    else { const int typ = g >> 5; b = (g >> 2) & 7; hq = g & 3; qrow = (size_t)b * TPB; pc = typ ? PC_C : PC_B; ocol = 512 + typ * 256 + hq * 64; NTl = 4; sink = typ == 1; }
    const float sinkl = sink ? c_in(16)[l * 4 + hq] * LOG2E : 0.f;
    const bf16* Kh = P + (size_t)b * TPB * NP + pc + 256 + (hq >> 1) * 64;
    attn_body::attn_unit<8>(P + qrow * NP + pc + hq * 64, Kh, Kh + 128, MIX + qrow * DM + ocol, NTl, woff, kq0, sinkl, sink, domask, shm, c.tid);
}
namespace gdn {
typedef short s16x4 __attribute__((ext_vector_type(4)));
typedef float f32x2_t __attribute__((ext_vector_type(2))); typedef __bf16 bf16x2_t __attribute__((ext_vector_type(2)));
__device__ __forceinline__ unsigned cvtpk(float lo, float hi) { f32x2_t v = {lo, hi}; bf16x2_t b = __builtin_convertvector(v, bf16x2_t); return __builtin_bit_cast(unsigned, b); }
__device__ __forceinline__ s16x4 pack4(const f32x4& v) { unsigned a = cvtpk(v[0], v[1]), b = cvtpk(v[2], v[3]); typedef unsigned u32x2 __attribute__((ext_vector_type(2))); u32x2 u = {a, b}; return __builtin_bit_cast(s16x4, u); }
__device__ __forceinline__ bf16x8 cat44(s16x4 a, s16x4 b) { return (bf16x8){a[0], a[1], a[2], a[3], b[0], b[1], b[2], b[3]}; }
template <int CTRL> __device__ __forceinline__ float dpp(float x) { return __builtin_bit_cast(float, __builtin_amdgcn_mov_dpp(__builtin_bit_cast(int, x), CTRL, 0xf, 0xf, true)); }
__device__ __forceinline__ float xrow16_sum(float x) {
    auto s = __builtin_amdgcn_permlane16_swap(__float_as_uint(x), __float_as_uint(x), false, false);
    x = __uint_as_float(s[0]) + __uint_as_float(s[1]);
    auto t = __builtin_amdgcn_permlane32_swap(__float_as_uint(x), __float_as_uint(x), false, false);
    return __uint_as_float(t[0]) + __uint_as_float(t[1]);
}
__device__ __forceinline__ float wsum64(float x) {
    x += dpp<0xB1>(x); x += dpp<0x4E>(x); x += dpp<0x124>(x); x += dpp<0x128>(x); return xrow16_sum(x);
}
__device__ __forceinline__ float rdlane(float v, int idx) { return __builtin_bit_cast(float, __builtin_amdgcn_readlane(__builtin_bit_cast(int, v), idx)); }
#define GD_MFMA(a, b, c) __builtin_amdgcn_mfma_f32_16x16x32_bf16((a), (b), (c), 0, 0, 0)
#define GD_BAR() asm volatile("s_waitcnt lgkmcnt(0)\n\ts_barrier" ::: "memory")
constexpr int RP = 72;
constexpr int LQS = 0  , LKS = 18432, LVS = 27648, LLM = 36864, LAM = 46080, LKET = 55296, LWL = 64512, LSTT = 73728, LDG = 82944, LDI = 87040, DIP = 24,
              LGC = 90112, LBETA = 90368, LEKL = 90624, LBGE = 90880, LEGC = 91136  , LSC = 91648, LDS_END = 91712;
#define GD_BF(off) ((LAS bf16*)(lds + (off)))
#define GD_F(off)  ((LAS float*)(lds + (off)))

__device__ __forceinline__ void gdn_fast_unit(const Ctx& c, int l, int u) {
    LAS unsigned char* lds = c.lds;
    const int d = u & 1, h = (u >> 1) & 7, b = u >> 4, lane0 = c.lane, w = c.wave;
#define GD_LANE() int lane = lane0; float zf_ = 0.f; asm volatile("" : "+v"(lane), "+v"(zf_)); const int g4 = lane >> 4, l15 = lane & 15; (void)g4; (void)l15; (void)zf_
#define GD_Z4 ((f32x4){zf_, zf_, zf_, zf_})
#define GD_IDENT(par_) ({ const unsigned hit_ = (g4 == 2 * (par_) + (l15 >> 3)) ? (0x3F80u << (16 * (l15 & 1))) : 0u; const int dw_ = (l15 & 7) >> 1; \
        const v4u id_ = (v4u){dw_ == 0 ? hit_ : 0u, dw_ == 1 ? hit_ : 0u, dw_ == 2 ? hit_ : 0u, dw_ == 3 ? hit_ : 0u}; __builtin_bit_cast(bf16x8, id_); })
    const bf16* Qn = (const bf16*)c_OG; const float* Gt = c_Gt; bf16* og = c_P + d * 512;
    const float Aexp = __expf(c_in(9)[l * 16 + d * 8 + h]), dtb = c_in(10)[l * 16 + d * 8 + h];
    f32x4 Sacc[4];
    { float zf_ = 0.f; asm volatile("" : "+v"(zf_));
#pragma unroll
    for (int rt = 0; rt < 4; ++rt) Sacc[rt] = GD_Z4; }
    for (int i = c.tid; i < 64 * RP / 2; i += NTHREADS) ((LAS unsigned*)(lds + LSTT))[i] = 0u;
#define GD_GEOM(cc_) const int seg = (cc_) >= 4, len = seg ? SEQ : CTXL, base = b * TPB + (seg ? CTXL : 0), ci = seg ? (cc_) - 4 : (cc_), c0 = d ? len - 64 - 64 * ci : 64 * ci; (void)len
#define GD_LOAD(cc_) do { GD_GEOM(cc_); GD_LANE(); \
        _Pragma("unroll") for (int jj = 0; jj < 2; ++jj) { const int r = 16 * (w - 4) + (lane >> 3) + 8 * jj; const bf16* pr = Qn + (size_t)(base + (d ? c0 + 63 - r : c0 + r)) * 1536 + h * 64 + 8 * (lane & 7); \
            rq[jj] = *(const v4u*)pr; rk[jj] = *(const v4u*)(pr + 512); rv[jj] = *(const v4u*)(pr + 1024); } \
        if (w == 4) { const int R = base + (d ? c0 + 63 - lane : c0 + lane); rbraw = Gt[(size_t)R * 32 + d * 8 + h]; raraw = Gt[(size_t)R * 32 + 16 + d * 8 + h]; } } while (0)
#define GD_STEP_A(cc_) do { GD_LANE(); const int set = (cc_) & 1; \
        asm volatile("" : "+v"(rq[0]), "+v"(rq[1]), "+v"(rk[0]), "+v"(rk[1]), "+v"(rv[0]), "+v"(rv[1])); \
        _Pragma("unroll") for (int jj = 0; jj < 2; ++jj) { const int r = 16 * (w - 4) + (lane >> 3) + 8 * jj, o_ = r * RP + 8 * (lane & 7); \
            *(LAS v4u*)(GD_BF(LQS) + set * (64 * RP) + o_) = rq[jj]; *(LAS v4u*)(GD_BF(LKS) + o_) = rk[jj]; *(LAS v4u*)(GD_BF(LVS) + o_) = rv[jj]; } \
        if (w == 4) { asm volatile("" : "+v"(rbraw), "+v"(raraw)); \
            const float beta = 1.f / (1.f + __expf(-rbraw)); \
            const float ar = raraw + dtb; const float sp = ar > 20.f ? ar : __logf(1.f + __expf(ar)); \
            float gc = -Aexp * sp; \
            gc += dpp<0x111>(gc); gc += dpp<0x112>(gc); gc += dpp<0x114>(gc); gc += dpp<0x118>(gc); \
            { const float t15 = rdlane(gc, 15), t31 = rdlane(gc, 31), t47 = rdlane(gc, 47); gc += (g4 >= 1 ? t15 : 0.f) + (g4 >= 2 ? t31 : 0.f) + (g4 >= 3 ? t47 : 0.f); } \
            const float gl = rdlane(gc, 63); const float egc = __expf(gc); \
            GD_F(LGC)[lane] = gc; GD_F(LBETA)[lane] = beta; GD_F(LEKL)[lane] = __expf(gl - gc); GD_F(LBGE)[lane] = beta * egc; GD_F(LEGC)[set * 64 + lane] = egc; \
            if (lane == 0) GD_F(LSC)[set] = __expf(gl); } } while (0)
    v4u rq[2], rk[2], rv[2]; float rbraw = 0.f, raraw = 0.f;
    if (w >= 4) { GD_LOAD(0); GD_STEP_A(0); GD_LOAD(1); }
    GD_BAR();
    for (int cc = 0; cc < 36; ++cc) {
        GD_GEOM(cc);
        const bool store_o = !(seg == 0 && l == NL - 1);
        const int set = cc & 1;
        f32x4 X[4];
        {
            GD_LANE();
            const int mat = w >> 2, ti = w & 3, i = 16 * ti + l15;
            LAS const bf16* Xs = mat ? GD_BF(LQS) + set * (64 * RP) : GD_BF(LKS);
            const bf16x8 x0 = *(LAS const bf16x8*)(Xs + i * RP + 8 * g4), x1 = *(LAS const bf16x8*)(Xs + i * RP + 32 + 8 * g4);
            const float gci = GD_F(LGC)[i], bti = mat ? 1.f : -GD_F(LBETA)[i];
            LAS bf16* Out = mat ? GD_BF(LAM) : GD_BF(LLM);
#pragma unroll
            for (int tj = 0; tj < 4; ++tj) {
                f32x4 o4 = GD_Z4;
                if (tj <= ti) {
                    const bf16x8 k0 = *(LAS const bf16x8*)(GD_BF(LKS) + (16 * tj + l15) * RP + 8 * g4), k1 = *(LAS const bf16x8*)(GD_BF(LKS) + (16 * tj + l15) * RP + 32 + 8 * g4);
                    const f32x4 gcj = *(LAS const f32x4*)(GD_F(LGC) + 16 * tj + 4 * g4);
                    f32x4 acc = GD_MFMA(k0, x0, GD_Z4); acc = GD_MFMA(k1, x1, acc);
#pragma unroll
                    for (int r = 0; r < 4; ++r) { const int j = 16 * tj + 4 * g4 + r; const float dec = __expf(fminf(gci - gcj[r], 0.f));
                        const bool keep = mat ? (i >= j) : (i > j); o4[r] = keep ? bti * acc[r] * dec : 0.f; }
                    if (tj == ti && mat == 0) {
#pragma unroll
                        for (int r = 0; r < 4; ++r) GD_F(LDG)[(ti * 16 + 4 * g4 + r) * 16 + l15] = -o4[r]; }
                }
                *(LAS s16x4*)(Out + i * RP + 16 * tj + 4 * g4) = pack4(o4);
            }
            { const int tt = w >> 1, ks = w & 1; const bf16x8 kf = *(LAS const bf16x8*)(GD_BF(LKS) + (16 * tt + l15) * RP + 32 * ks + 8 * g4);
              const f32x4 ek = *(LAS const f32x4*)(GD_F(LEKL) + 16 * tt + 4 * g4);
#pragma unroll
              for (int par = 0; par < 2; ++par) { const f32x4 kt = GD_MFMA(kf, GD_IDENT(par), GD_Z4) * ek;
                  *(LAS s16x4*)(GD_BF(LKET) + (32 * ks + 16 * par + l15) * RP + 16 * tt + 4 * g4) = pack4(kt); } }
        }
        GD_BAR();
        if (w == 0) {
            GD_LANE();
            const int bb = lane >> 4, cc2 = lane & 15; LAS const float* NTr = GD_F(LDG) + bb * 256;
            float x[16];
#pragma unroll
            for (int i = 0; i < 16; ++i) x[i] = (i == cc2) ? 1.f : 0.f;
#define GD_ELIM(J0, J1) { f32x4 n[(J1 - J0 + 1) * 4]; \
            _Pragma("unroll") for (int j = J0; j <= J1; ++j) _Pragma("unroll") for (int q = (j + 1) >> 2; q < 4; ++q) n[(j - J0) * 4 + q] = *(LAS const f32x4*)(NTr + j * 16 + 4 * q); \
            asm volatile("s_waitcnt lgkmcnt(0)" ::: "memory"); \
            _Pragma("unroll") for (int j = J0; j <= J1; ++j) _Pragma("unroll") for (int i = j + 1; i < 16; ++i) x[i] -= n[(j - J0) * 4 + (i >> 2)][i & 3] * x[j]; }
            GD_ELIM(0, 6) GD_ELIM(7, 14)
#undef GD_ELIM
#pragma unroll
            for (int i = 0; i < 16; ++i) GD_BF(LDI)[(bb * 16 + i) * DIP + cc2] = (bf16)(cvtpk(x[i], 0.f) & 0xffffu);
        }
        GD_BAR();
        {
            GD_LANE();
            s16x4 Xp[4]; const s16x4 z4 = (s16x4){0, 0, 0, 0};
            f32x4 Yin[4]; s16x4 la1, la2, lb2, la3, lb3, lc3, di[4];
            { const int cw = w & 3; LAS const bf16* Src = (w < 4 ? GD_BF(LVS) : GD_BF(LKS)) + l15 * RP + 32 * (cw >> 1) + 8 * g4; LAS const float* Sc = GD_F(w < 4 ? LBETA : LBGE) + 4 * g4;
              const bf16x8 idn = GD_IDENT(cw & 1);
#pragma unroll
              for (int bb = 0; bb < 4; ++bb) { Yin[bb] = GD_MFMA(*(LAS const bf16x8*)(Src + 16 * bb * RP), idn, GD_Z4) * *(LAS const f32x4*)(Sc + 16 * bb);
                  di[bb] = *(LAS const s16x4*)(GD_BF(LDI) + (bb * 16 + l15) * DIP + 4 * g4); } }
            { LAS const bf16* lr = GD_BF(LLM) + l15 * RP + 4 * g4; la1 = *(LAS const s16x4*)(lr + 16 * RP); la2 = *(LAS const s16x4*)(lr + 32 * RP); lb2 = *(LAS const s16x4*)(lr + 32 * RP + 16);
              la3 = *(LAS const s16x4*)(lr + 48 * RP); lb3 = *(LAS const s16x4*)(lr + 48 * RP + 16); lc3 = *(LAS const s16x4*)(lr + 48 * RP + 32); }
            X[0] = GD_MFMA(cat44(di[0], z4), cat44(pack4(Yin[0]), z4), GD_Z4); Xp[0] = pack4(X[0]);
            f32x4 Y = GD_MFMA(cat44(la1, z4), cat44(Xp[0], z4), Yin[1]);
            X[1] = GD_MFMA(cat44(di[1], z4), cat44(pack4(Y), z4), GD_Z4); Xp[1] = pack4(X[1]);
            Y = GD_MFMA(cat44(la2, lb2), cat44(Xp[0], Xp[1]), Yin[2]);
            X[2] = GD_MFMA(cat44(di[2], z4), cat44(pack4(Y), z4), GD_Z4); Xp[2] = pack4(X[2]);
            Y = GD_MFMA(cat44(la3, lb3), cat44(Xp[0], Xp[1]), Yin[3]); Y = GD_MFMA(cat44(lc3, z4), cat44(Xp[2], z4), Y);
            X[3] = GD_MFMA(cat44(di[3], z4), cat44(pack4(Y), z4), GD_Z4);
            if (w >= 4) {
#pragma unroll
                for (int bb = 0; bb < 4; ++bb)
#pragma unroll
                    for (int r = 0; r < 4; ++r) GD_BF(LWL)[(16 * bb + 4 * g4 + r) * RP + 16 * (w - 4) + l15] = (bf16)(cvtpk(-X[bb][r], 0.f) & 0xffffu);
            }
        }
        GD_BAR();
        if (w < 4) {
            GD_LANE();
            LAS const bf16* Qs = GD_BF(LQS) + set * (64 * RP);
            const bf16x8 sb0 = *(LAS const bf16x8*)(GD_BF(LSTT) + (16 * w + l15) * RP + 8 * g4), sb1 = *(LAS const bf16x8*)(GD_BF(LSTT) + (16 * w + l15) * RP + 32 + 8 * g4);
            f32x4 Vn[4], O[4];
#pragma unroll
            for (int hp = 0; hp < 2; ++hp) { bf16x8 wf[2][2], qf[2][2]; f32x4 eg[2];
#pragma unroll
                for (int q = 0; q < 2; ++q) { const int rt = 2 * hp + q; LAS const bf16* wr = GD_BF(LWL) + (16 * rt + l15) * RP + 8 * g4; LAS const bf16* qr = Qs + (16 * rt + l15) * RP + 8 * g4;
                    wf[q][0] = *(LAS const bf16x8*)(wr); wf[q][1] = *(LAS const bf16x8*)(wr + 32); qf[q][0] = *(LAS const bf16x8*)(qr); qf[q][1] = *(LAS const bf16x8*)(qr + 32);
                    eg[q] = *(LAS const f32x4*)(GD_F(LEGC) + set * 64 + 16 * rt + 4 * g4); }
#pragma unroll
                for (int q = 0; q < 2; ++q) { const int rt = 2 * hp + q; Vn[rt] = GD_MFMA(wf[q][0], sb0, X[rt]); Vn[rt] = GD_MFMA(wf[q][1], sb1, Vn[rt]);
                    f32x4 t = GD_MFMA(qf[q][0], sb0, GD_Z4); t = GD_MFMA(qf[q][1], sb1, t); O[rt] = t * eg[q]; } }
            const bf16x8 vp0 = cat44(pack4(Vn[0]), pack4(Vn[1])), vp1 = cat44(pack4(Vn[2]), pack4(Vn[3]));
            const float egl = GD_F(LSC)[set];
#pragma unroll
            for (int hp = 0; hp < 2; ++hp) { bf16x8 af[2][2], kf[2][2];
#pragma unroll
                for (int q = 0; q < 2; ++q) { const int rt = 2 * hp + q; LAS const bf16* ar = GD_BF(LAM) + (16 * rt + l15) * RP + 4 * g4; LAS const bf16* kr = GD_BF(LKET) + (16 * rt + l15) * RP + 4 * g4;
                    af[q][0] = cat44(*(LAS const s16x4*)(ar), *(LAS const s16x4*)(ar + 16)); af[q][1] = cat44(*(LAS const s16x4*)(ar + 32), *(LAS const s16x4*)(ar + 48));
                    kf[q][0] = cat44(*(LAS const s16x4*)(kr), *(LAS const s16x4*)(kr + 16)); kf[q][1] = cat44(*(LAS const s16x4*)(kr + 32), *(LAS const s16x4*)(kr + 48)); }
#pragma unroll
                for (int q = 0; q < 2; ++q) { const int rt = 2 * hp + q; O[rt] = GD_MFMA(af[q][0], vp0, O[rt]); O[rt] = GD_MFMA(af[q][1], vp1, O[rt]);
                    f32x4 S2 = Sacc[rt] * egl; S2 = GD_MFMA(kf[q][0], vp0, S2); S2 = GD_MFMA(kf[q][1], vp1, S2); Sacc[rt] = S2; } }
#pragma unroll
            for (int rt = 0; rt < 4; ++rt) *(LAS s16x4*)(GD_BF(LSTT) + (16 * w + l15) * RP + 16 * rt + 4 * g4) = pack4(Sacc[rt]);
            if (store_o) {
#pragma unroll
                for (int rt = 0; rt < 4; ++rt)
#pragma unroll
                    for (int r = 0; r < 4; ++r) { const int i = 16 * rt + 4 * g4 + r; const int R = base + (d ? c0 + 63 - i : c0 + i); og[(size_t)R * NP + h * 64 + 16 * w + l15] = (bf16)(cvtpk(O[rt][r], 0.f) & 0xffffu); }
            }
        } else if (cc + 1 < 36) {
            GD_STEP_A(cc + 1);
            if (cc + 2 < 36) GD_LOAD(cc + 2);
        }
        GD_BAR();
    }
#undef GD_GEOM
#undef GD_LOAD
#undef GD_STEP_A
#undef GD_LANE
#undef GD_Z4
#undef GD_IDENT
}
#undef GD_BF
#undef GD_F
}

__device__ __forceinline__ void gdn_qkv_phase(Ctx& c, int l) {
    const bf16* P = c_P; bf16* Qn = (bf16*)c_OG; const int lane = c.lane;
    const float* cw = c_in(8) + (size_t)l * 5 * 1536;
    for (int it = c.gw; it < (NT / 8) * 4; it += c.NGW) {
        const int hp = it & 3, blk = it >> 2, R0 = blk * 8; const int b = R0 / TPB, tp0 = R0 - b * TPB; const bool isctx = tp0 < CTXL;
        const int len = isctx ? CTXL : SEQ, base = b * TPB + (isctx ? 0 : CTXL), tb = tp0 - (isctx ? 0 : CTXL);
        const int col = hp * 128 + 2 * lane;
        unsigned rq[12], rk[12], rv[12];
#pragma unroll
        for (int m = 0; m < 12; ++m) { int tok = tb - 2 + m; tok = tok < 0 ? 0 : (tok >= len ? len - 1 : tok); const unsigned* pr = (const unsigned*)(P + (size_t)(base + tok) * NP + col); rq[m] = pr[0]; rk[m] = pr[256]; rv[m] = pr[512]; }
        f32x2v wq[5], wk[5], wv[5];
#pragma unroll
        for (int j = 0; j < 5; ++j) { wq[j] = *(const f32x2v*)(cw + j * 1536 + col); wk[j] = *(const f32x2v*)(cw + j * 1536 + 512 + col); wv[j] = *(const f32x2v*)(cw + j * 1536 + 1024 + col); }
        f32x2v xq[12], xk[12], xv[12];
#pragma unroll
        for (int m = 0; m < 12; ++m) { const int tok = tb - 2 + m; const float vm = (tok >= 0 && tok < len) ? 1.f : 0.f;
            xq[m] = (f32x2v){__builtin_bit_cast(float, rq[m] << 16), __builtin_bit_cast(float, rq[m] & 0xffff0000u)} * vm;
            xk[m] = (f32x2v){__builtin_bit_cast(float, rk[m] << 16), __builtin_bit_cast(float, rk[m] & 0xffff0000u)} * vm;
            xv[m] = (f32x2v){__builtin_bit_cast(float, rv[m] << 16), __builtin_bit_cast(float, rv[m] & 0xffff0000u)} * vm; }
#pragma unroll
        for (int i = 0; i < 8; ++i) { f32x2v aq = wq[0] * xq[i], ak = wk[0] * xk[i], av = wv[0] * xv[i];
#pragma unroll
            for (int j = 1; j < 5; ++j) { aq += wq[j] * xq[i + j]; ak += wk[j] * xk[i + j]; av += wv[j] * xv[i + j]; }
            f32x2v yq, yk, yv;
#pragma unroll
            for (int e = 0; e < 2; ++e) { yq[e] = aq[e] * __builtin_amdgcn_rcpf(1.f + __expf(-aq[e])); yk[e] = ak[e] * __builtin_amdgcn_rcpf(1.f + __expf(-ak[e])); yv[e] = av[e] * __builtin_amdgcn_rcpf(1.f + __expf(-av[e])); }
            float sq = yq[0] * yq[0] + yq[1] * yq[1], sk = yk[0] * yk[0] + yk[1] * yk[1];
            sq += gdn::dpp<0xB1>(sq); sk += gdn::dpp<0xB1>(sk); sq += gdn::dpp<0x4E>(sq); sk += gdn::dpp<0x4E>(sk); sq += gdn::dpp<0x124>(sq); sk += gdn::dpp<0x124>(sk); sq += gdn::dpp<0x128>(sq); sk += gdn::dpp<0x128>(sk);
            { auto s1 = __builtin_amdgcn_permlane16_swap(__float_as_uint(sq), __float_as_uint(sq), false, false); sq = __uint_as_float(s1[0]) + __uint_as_float(s1[1]);
              auto s2 = __builtin_amdgcn_permlane16_swap(__float_as_uint(sk), __float_as_uint(sk), false, false); sk = __uint_as_float(s2[0]) + __uint_as_float(s2[1]); }
            const float rq_ = rsqrtf(sq + 1e-6f) * 0.125f, rk_ = rsqrtf(sk + 1e-6f);
            unsigned* o = (unsigned*)(Qn + (size_t)(R0 + i) * 1536 + col);
            o[0] = gdn::cvtpk(yq[0] * rq_, yq[1] * rq_); o[256] = gdn::cvtpk(yk[0] * rk_, yk[1] * rk_); o[512] = gdn::cvtpk(yv[0], yv[1]); }
    }
}

__device__ __forceinline__ void mixer_phase(Ctx& c, int l, int rep = 0) {
    unsigned* ctr = (unsigned*)(c.A->ws + WS_CTL) + CW_Q + 128 * l + 64 * rep;
    volatile LAS unsigned* slot = (volatile LAS unsigned*)(c.lds + MISC_OFF) + 16;
    const int nitems = (128 + 512 + (l == 0 ? 64 : 0)) * (DUP == 33 ? 2 : 1);
    for (;;) {
        if (c.tid == 0) slot[0] = __hip_atomic_fetch_add(ctr, 1u, __ATOMIC_RELAXED, __HIP_MEMORY_SCOPE_AGENT);
        __syncthreads();
        int item = __builtin_amdgcn_readfirstlane((int)slot[0]);
        __syncthreads();
        if (item >= nitems) break;
        if (DUP == 33) item >>= 1;
        Ctx ci = c;
        { int w_ = c.wave; asm volatile("" : "+s"(w_)); int l_; asm volatile("v_mbcnt_lo_u32_b32 %0, -1, 0\n\tv_mbcnt_hi_u32_b32 %0, -1, %0" : "=v"(l_)); ci.wave = w_; ci.lane = l_; ci.tid = w_ * 64 + l_; }
        if (item < 128) gdn::gdn_fast_unit(ci, l, item);
        else { const int a = item - 128; attn_item(ci, l, a < 256 ? 0 : (a < 512 ? 1 : 2), a & 255); }
    }
}

__device__ __forceinline__ void gdn_combine_phase(Ctx& c, int l) {
    const float* gn = c_in(11) + l * 64; const bf16* P = c_P; bf16* MIX = c_ACT; const int lane = c.lane;
    const f32x4 g0 = *(const f32x4*)(gn + 8 * (lane & 7)), g1 = *(const f32x4*)(gn + 8 * (lane & 7) + 4);
    for (int R = c.gw; R < NT; R += c.NGW) {
        if (l == NL - 1 && (R % TPB) < CTXL) continue;
        const bf16x8 of = *(const bf16x8*)(P + (size_t)R * NP + 8 * lane), ob = *(const bf16x8*)(P + (size_t)R * NP + 512 + 8 * lane);
        const bf16x8 zr = *(const bf16x8*)(P + (size_t)R * NP + PC_Z + 8 * lane);
        f32x4 v0, v1;
#pragma unroll
        for (int e = 0; e < 4; ++e) { v0[e] = bfs2f(of[e]) + bfs2f(ob[e]); v1[e] = bfs2f(of[4 + e]) + bfs2f(ob[4 + e]); }
        float ss = (v0[0] * v0[0] + v0[1] * v0[1]) + (v0[2] * v0[2] + v0[3] * v0[3]) + (v1[0] * v1[0] + v1[1] * v1[1]) + (v1[2] * v1[2] + v1[3] * v1[3]);
        ss += lane_xor(ss, 1, lane); ss += lane_xor(ss, 2, lane); ss += lane_xor(ss, 4, lane);
        const float rstd = rsqrtf(ss * (1.f / 64.f) + RMS_EPS);
        float y[8];
#pragma unroll
        for (int e = 0; e < 8; ++e) y[e] = (e < 4 ? v0[e] * g0[e] : v1[e - 4] * g1[e - 4]) * rstd * siluf(bfs2f(zr[e]));
        v4u o; o.x = pk2(y[0], y[1]); o.y = pk2(y[2], y[3]); o.z = pk2(y[4], y[5]); o.w = pk2(y[6], y[7]);
        *(v4u*)(MIX + (size_t)R * DM + 8 * lane) = o;
    }
}

__global__ void __launch_bounds__(NTHREADS, 2) mk_fwd(Args args) {
    extern __shared__ __attribute__((aligned(16))) unsigned char lds_raw[];
    typedef const __attribute__((address_space(4))) Args* KArgs;
    int wave_sgpr, lo, hi; unsigned char* ws;
    XcdBarrier bar;
    {
        const int tid0 = threadIdx.x; wave_sgpr = __builtin_amdgcn_readfirstlane(tid0 >> 6);
        KArgs A0 = (KArgs)__builtin_amdgcn_kernarg_segment_ptr();
        ws = A0->ws; lo = A0->ph_lo; hi = A0->ph_hi;
        LAS unsigned char* l0 = (LAS unsigned char*)lds_raw;
        for (int u = tid0; u < (LDS_BYTES - 131072) / 4; u += NTHREADS) ((LAS unsigned*)(l0 + 131072))[u] = 0u;
        __syncthreads();
        unsigned* barw = (unsigned*)(ws + WS_CTL) + CW_BAR + A0->li * XCD_BAR_WORDS;
        bar.bar = barw; bar.x = 0; bar.st = nullptr;
        if (hi - lo > 1) bar = xcd_barrier_post(barw, (volatile LAS unsigned*)(l0 + MISC_OFF) + 8, tid0 == 0);
    }
#ifndef ONLY
#define ONLY -1
#endif
#define EN(k) (ONLY < 0 || ONLY == (k))
#define PHASE(k, ...) do { const int k_ = (k); if (lo <= k_ && k_ < hi) { Ctx c; \
        { KArgs ap_ = (KArgs)__builtin_amdgcn_kernarg_segment_ptr(); asm volatile("" : "+s"(ap_)); c.A = ap_; } \
        { int w_ = wave_sgpr; asm volatile("" : "+s"(w_)); int l_; asm volatile("v_mbcnt_lo_u32_b32 %0, -1, 0\n\tv_mbcnt_hi_u32_b32 %0, -1, %0" : "=v"(l_)); \
          c.wave = w_; c.lane = l_; c.tid = w_ * 64 + l_; c.G = gridDim.x; c.bx = blockIdx.x; c.gw = c.bx * NWAVES + w_; c.NGW = c.G * NWAVES; c.lds = (LAS unsigned char*)lds_raw; } \
        { __VA_ARGS__ } if (DUP >= 0 && DUP != 5 && DUP != 8 && DUP != 2 && DUP != 3 && DUP == (k_ == 0 ? 10 : (k_ - 1) % 9)) { if (k_ > 0) __syncthreads(); __VA_ARGS__ } \
        if (k_ + 1 < hi) { xcd_barrier(bar, c.tid == 0); if (DUP == 20) xcd_barrier(bar, c.tid == 0); } } } while (0)
    PHASE(0, if (EN(10)) conv_weights(c, 0); __syncthreads(); if (EN(11)) ada_mod_phase(c););
#pragma unroll 1
    for (int l = 0; l < NL; ++l) {
        const int p0 = 1 + 9 * l; const bool last = (l == NL - 1);
        PHASE(p0 + 0, if (EN(0)) { if (l > 0) { conv_weights(c, l); __syncthreads(); } norm_phase(c, l, 0); });
        PHASE(p0 + 1, if (EN(1)) { pg8::Gemm g{c_ACT, c_Win_t, NT, NPG, DM, DM}; pg8::RowOrder S; S.init(NPG, c.G, c.bx, false); pg8::EpiInProjG E{c_P, c_Gt};
                  pg8::gemm_phase<pg8::EpiInProjG, pg8::RowOrder, true, true>(c.lds, g, S, E, c.tid); });
        PHASE(p0 + 2, if (EN(2)) { for (int rep_ = 0; rep_ < (DUP == 2 ? 2 : 1); ++rep_) attn_prep_phase(c, l, rep_ > 0); for (int r41_ = 0; r41_ < (DUP == 41 ? 2 : 1); ++r41_) gdn_qkv_phase(c, l); });
        PHASE(p0 + 3, if (EN(3)) { for (int rep_ = 0; rep_ < (DUP == 3 ? 2 : 1); ++rep_) { if (rep_) xcd_barrier(bar, c.tid == 0); mixer_phase(c, l, rep_); __syncthreads(); } });
        PHASE(p0 + 4, if (EN(4)) gdn_combine_phase(c, l););
        PHASE(p0 + 5, if (EN(5)) { for (int rep_ = 0; rep_ < (DUP == 5 ? 2 : 1); ++rep_) {
                { pg8::Gemm g{c_ACT, c_Wout_t, NT, DM, DM, DM}; pg8::RowOrder S; S.init(DM, c.G, c.bx, true);
                  pg8::EpiGateRes E{c_XSC, c_out, rep_ ? (const float*)(c.A->ws + WS_CTL + 512 * 1024) : c_MOD + (size_t)l * 9 * NMODC + 2 * DM};
                  pg8::gemm_phase<pg8::EpiGateRes, pg8::RowOrder, true, true>(c.lds, g, S, E, c.tid); }
                if (!last) { __syncthreads();
                  pg8::Gemm g{c_ACT, c_Wout_t, NT, DM, DM / 4, DM}; pg8::CtxSplitOrder S; S.init(c.G, c.bx, 4, DM); pg8::EpiSlab E{c_OG, 4, DM / 4};
                  pg8::gemm_phase<pg8::EpiSlab, pg8::CtxSplitOrder, true, true>(c.lds, g, S, E, c.tid); } } });
        PHASE(p0 + 6, if (EN(6)) norm_phase(c, l, 1););
        PHASE(p0 + 7, if (EN(7)) { pg8::Gemm g{c_ACT, c_W1_t, NT, DFF, DM, DM}; pg8::RowOrder S; S.init(DFF, c.G, c.bx, last); pg8::EpiBf16<2> E{c_H, DFF, nullptr, 0, 0, 1.f};
                  pg8::gemm_phase<pg8::EpiBf16<2>, pg8::RowOrder, true, true>(c.lds, g, S, E, c.tid); });
        PHASE(p0 + 8, if (EN(8)) { for (int rep_ = 0; rep_ < (DUP == 8 ? 2 : 1); ++rep_) {
                { pg8::Gemm g{c_H, c_W2_t, NT, DM, DFF, DFF}; pg8::RowOrder S; S.init(DM, c.G, c.bx, true);
                  pg8::EpiGateRes E{c_XSC, c_out, rep_ ? (const float*)(c.A->ws + WS_CTL + 512 * 1024) : c_MOD + (size_t)l * 9 * NMODC + 5 * DM};
                  pg8::gemm_phase<pg8::EpiGateRes, pg8::RowOrder, true, true>(c.lds, g, S, E, c.tid); }
                if (!last) { __syncthreads();
                  pg8::Gemm g{c_H, c_W2_t, NT, DM, DFF / 4, DFF}; pg8::CtxSplitOrder S; S.init(c.G, c.bx, 4, DFF); pg8::EpiSlab E{(float*)(c.A->ws + WS_SLAB), 4, DFF / 4};
                  pg8::gemm_phase<pg8::EpiSlab, pg8::CtxSplitOrder, true, true>(c.lds, g, S, E, c.tid); } } });
    }
}

#if !MIXER_IN_MAIN
__global__ void __launch_bounds__(NTHREADS, 2) mixer_k(Args args, int l) {
    extern __shared__ __attribute__((aligned(16))) unsigned char lds_raw2[];
    Ctx c; c.A = (const __attribute__((address_space(4))) Args*)__builtin_amdgcn_kernarg_segment_ptr();
    c.tid = threadIdx.x; c.lane = c.tid & 63; c.wave = __builtin_amdgcn_readfirstlane(c.tid >> 6); c.G = gridDim.x; c.bx = blockIdx.x; c.gw = c.bx * NWAVES + c.wave; c.NGW = c.G * NWAVES; c.lds = (LAS unsigned char*)lds_raw2;
    if (c.wave == 0 && c.bx < 128) gdn_naive_unit(c, l, c.bx, (LAS float*)c.lds);
}
#endif
extern "C" void kernel_launch(void* const* d_in, const int* in_sizes, int n_in, void* d_out, int out_size, void* d_ws, size_t ws_size, hipStream_t stream) {
    static int grid = 0;
    if (grid == 0) {
        if (n_in != 21 || out_size != NB * SEQ * DM || ws_size < WS_END) { fprintf(stderr, "kernel_launch: unexpected problem (n_in %d out %d ws %zu)\n", n_in, out_size, ws_size); grid = -1; return; }
        int dev = 0, cus = 0;
        if (hipGetDevice(&dev) != hipSuccess || hipDeviceGetAttribute(&cus, hipDeviceAttributeMultiprocessorCount, dev) != hipSuccess) { grid = -1; return; }
        if (hipFuncSetAttribute((const void*)mk_fwd, hipFuncAttributeMaxDynamicSharedMemorySize, LDS_BYTES) != hipSuccess) { fprintf(stderr, "kernel_launch: hipFuncSetAttribute failed\n"); grid = -1; return; }
        int per_cu = 0;
        if (hipOccupancyMaxActiveBlocksPerMultiprocessor(&per_cu, (const void*)mk_fwd, NTHREADS, LDS_BYTES) != hipSuccess || per_cu < 1) fprintf(stderr, "kernel_launch: occupancy query says %d\n", per_cu);
        (void)hipGetLastError();
        grid = cus;
    }
    if (grid < 0) return;
    if (hipMemsetAsync((char*)d_ws + WS_CTL, 0, CTL_ZERO_BYTES, stream) != hipSuccess) return;
    Args a{};
    for (int i = 0; i < 21; ++i) a.in[i] = (const float*)d_in[i];
    a.out = (float*)d_out; a.ws = (unsigned char*)d_ws;
#if MK_ONE_LAUNCH && MIXER_IN_MAIN
    a.ph_lo = 0; a.ph_hi = NPHASES; a.li = 0;
    hipLaunchKernelGGL(mk_fwd, dim3(grid), dim3(NTHREADS), LDS_BYTES, stream, a);
#elif MK_ONE_LAUNCH
    (void)hipFuncSetAttribute((const void*)mixer_k, hipFuncAttributeMaxDynamicSharedMemorySize, LDS_BYTES);
    for (int l = 0; l < NL; ++l) {
        a.ph_lo = l == 0 ? 0 : 1 + 9 * l - 6; a.ph_hi = 1 + 9 * l + 3; a.li = l;
        hipLaunchKernelGGL(mk_fwd, dim3(grid), dim3(NTHREADS), LDS_BYTES, stream, a);
        hipLaunchKernelGGL(mixer_k, dim3(grid), dim3(NTHREADS), LDS_BYTES, stream, a, l);
    }
    a.ph_lo = 1 + 9 * (NL - 1) + 3; a.ph_hi = NPHASES; a.li = NL;
    hipLaunchKernelGGL(mk_fwd, dim3(grid), dim3(NTHREADS), LDS_BYTES, stream, a);
#else
    for (int ph = 0; ph < NPHASES; ++ph) { a.ph_lo = ph; a.ph_hi = ph + 1; a.li = ph;
        hipLaunchKernelGGL(mk_fwd, dim3(grid), dim3(NTHREADS), LDS_BYTES, stream, a); }
#endif
}
```
